# Optimizing an MI355X kernel written in HIP

```python
import math
import jax, jax.numpy as jnp
from jax import lax
import numpy as np

D_MODEL = 1024
BATCH = 8
SEQ = 2048
DEPTH = 1

EPS = 1e-6
D_FF = 2816
FFN_RES_WEIGHT = 0.5
N_MOD = 9

SWA_HEADS = 8
SWA_KV_HEADS = 2
SWA_HEAD_DIM = 64
SWA_GROUP = SWA_HEADS // SWA_KV_HEADS
WINDOW = 128

MLA_HEADS = 4
MLA_Q_RANK = 256
MLA_KV_RANK = 128
MLA_NOPE = 128
MLA_ROPE = 64
MLA_V = 128
ROPE_THETA = 10000.0
Q_BLOCK = 128

NUM_BUCKETS = 32
MAX_DISTANCE = 128

IN_SPLITS = (SWA_HEADS * SWA_HEAD_DIM, SWA_KV_HEADS * SWA_HEAD_DIM, SWA_KV_HEADS * SWA_HEAD_DIM,
             MLA_Q_RANK, MLA_KV_RANK, MLA_ROPE)
D_IN = sum(IN_SPLITS)
MIX_OUT = SWA_HEADS * SWA_HEAD_DIM + MLA_HEADS * MLA_V

kernel_name = "hybrid_swa_sink_mla_macaron_adaln"


def rms_norm(x, g):
    xf = x.astype(jnp.float32)
    y = xf * lax.rsqrt(jnp.mean(xf * xf, axis=-1, keepdims=True) + EPS)
    return (y * g.astype(jnp.float32)).astype(x.dtype)


def modulate(h, shift, scale):
    return h * (1 + scale[:, None, :]) + shift[:, None, :]


def swiglu(h, w_gate, w_up, w_down):
    return (jax.nn.silu(h @ w_gate) * (h @ w_up)) @ w_down


def t5_bucket(dist):
    max_exact = NUM_BUCKETS // 2
    n = jnp.maximum(dist, 0)
    nf = jnp.maximum(n, 1).astype(jnp.float32)
    large = max_exact + (jnp.log(nf / max_exact) / math.log(MAX_DISTANCE / max_exact)
                         * (NUM_BUCKETS - max_exact)).astype(jnp.int32)
    large = jnp.minimum(large, NUM_BUCKETS - 1)
    return jnp.where(n < max_exact, n, large)


def rope_tables(seq, dim):
    inv = ROPE_THETA ** (-jnp.arange(0, dim, 2, dtype=jnp.float32) / dim)
    ang = jnp.arange(seq, dtype=jnp.float32)[:, None] * inv[None, :]
    return jnp.cos(ang), jnp.sin(ang)


def apply_rope(x, cos, sin):
    c = cos[None, :, None, :].astype(x.dtype)
    s = sin[None, :, None, :].astype(x.dtype)
    x1, x2 = jnp.split(x, 2, axis=-1)
    return jnp.concatenate([x1 * c - x2 * s, x2 * c + x1 * s], axis=-1)


def sliding_window_gqa(q, k, v, sinks, rel_bias):
    B, S = q.shape[0], q.shape[1]
    nb = S // WINDOW
    qb = q.reshape(B, nb, WINDOW, SWA_KV_HEADS, SWA_GROUP, SWA_HEAD_DIM)
    kb = k.reshape(B, nb, WINDOW, SWA_KV_HEADS, SWA_HEAD_DIM)
    vb = v.reshape(B, nb, WINDOW, SWA_KV_HEADS, SWA_HEAD_DIM)
    pad_k = jnp.zeros_like(kb[:, :1])
    kk = jnp.concatenate([jnp.concatenate([pad_k, kb[:, :-1]], axis=1), kb], axis=2)
    vv = jnp.concatenate([jnp.concatenate([jnp.zeros_like(vb[:, :1]), vb[:, :-1]], axis=1), vb], axis=2)

    s = jnp.einsum('bnqhgd,bnkhd->bnhgqk', qb, kk).astype(jnp.float32) * (SWA_HEAD_DIM ** -0.5)

    qi = jnp.arange(WINDOW)[:, None]
    kj = jnp.arange(2 * WINDOW)[None, :]
    dist = qi + WINDOW - kj
    band = (dist >= 0) & (dist < WINDOW)
    blk = jnp.arange(nb)[:, None]
    key_ok = (blk > 0) | (jnp.arange(2 * WINDOW)[None, :] >= WINDOW)
    valid = band[None, :, :] & key_ok[:, None, :]

    bias = rel_bias.astype(jnp.float32)[t5_bucket(dist)]
    bias = bias.transpose(2, 0, 1).reshape(SWA_KV_HEADS, SWA_GROUP, WINDOW, 2 * WINDOW)
    s = jnp.where(valid[None, :, None, None], s + bias[None, None], -jnp.inf)

    sink = jnp.broadcast_to(sinks.astype(jnp.float32).reshape(1, 1, SWA_KV_HEADS, SWA_GROUP, 1, 1),
                            s.shape[:-1] + (1,))
    p = jax.nn.softmax(jnp.concatenate([s, sink], axis=-1), axis=-1)[..., :-1]
    o = jnp.einsum('bnhgqk,bnkhd->bnqhgd', p.astype(vv.dtype), vv)
    return o.reshape(B, S, SWA_HEADS * SWA_HEAD_DIM)


def mla_attention(q_lat, kv_lat, k_rope, q_norm, kv_norm, w_uq, w_ukv):
    B, S = q_lat.shape[0], q_lat.shape[1]
    cos, sin = rope_tables(S, MLA_ROPE)
    q = (rms_norm(q_lat, q_norm) @ w_uq).reshape(B, S, MLA_HEADS, MLA_NOPE + MLA_ROPE)
    q_nope, q_rope = q[..., :MLA_NOPE], apply_rope(q[..., MLA_NOPE:], cos, sin)
    kv = (rms_norm(kv_lat, kv_norm) @ w_ukv).reshape(B, S, MLA_HEADS, MLA_NOPE + MLA_V)
    k_nope, v = kv[..., :MLA_NOPE], kv[..., MLA_NOPE:]
    k_r = apply_rope(k_rope[:, :, None, :], cos, sin)[:, :, 0, :]
    scale = (MLA_NOPE + MLA_ROPE) ** -0.5

    nb = S // Q_BLOCK
    qn = q_nope.reshape(B, nb, Q_BLOCK, MLA_HEADS, MLA_NOPE).transpose(1, 0, 2, 3, 4)
    qr = q_rope.reshape(B, nb, Q_BLOCK, MLA_HEADS, MLA_ROPE).transpose(1, 0, 2, 3, 4)
    kpos = jnp.arange(S)

    def one_block(args):
        qn_b, qr_b, i = args
        s = (jnp.einsum('bqhd,bkhd->bhqk', qn_b, k_nope)
             + jnp.einsum('bqhd,bkd->bhqk', qr_b, k_r)).astype(jnp.float32) * scale
        qpos = i * Q_BLOCK + jnp.arange(Q_BLOCK)
        s = jnp.where(kpos[None, :] <= qpos[:, None], s, -jnp.inf)
        p = jax.nn.softmax(s, axis=-1).astype(v.dtype)
        return jnp.einsum('bhqk,bkhd->bqhd', p, v)

    o = lax.map(one_block, (qn, qr, jnp.arange(nb)))
    return o.transpose(1, 0, 2, 3, 4).reshape(B, S, MLA_HEADS * MLA_V)


def token_mixing(h, w_in, q_norm, kv_norm, w_uq, w_ukv, sinks, w_o, rel_bias):
    B, S = h.shape[0], h.shape[1]
    proj = h @ w_in
    idx = np.cumsum(IN_SPLITS)[:-1].tolist()
    q_a, k_a, v_a, q_lat, kv_lat, k_rope = jnp.split(proj, idx, axis=-1)
    out_a = sliding_window_gqa(q_a.reshape(B, S, SWA_HEADS, SWA_HEAD_DIM),
                               k_a.reshape(B, S, SWA_KV_HEADS, SWA_HEAD_DIM),
                               v_a.reshape(B, S, SWA_KV_HEADS, SWA_HEAD_DIM),
                               sinks, rel_bias)
    out_b = mla_attention(q_lat, kv_lat, k_rope, q_norm, kv_norm, w_uq, w_ukv)
    return jnp.concatenate([out_a, out_b], axis=-1) @ w_o


def setup_inputs(seed: int = 0) -> dict:
    key = jax.random.key(seed)
    ks = jax.random.split(key, 24)
    L, D = DEPTH, D_MODEL

    def w(k, shape, fan_in):
        return jax.random.normal(k, shape, jnp.float32) * fan_in ** -0.5

    def gain(k, shape):
        return 1.0 + 0.05 * jax.random.normal(k, shape, jnp.float32)

    return {
        "x": jax.random.normal(ks[0], (BATCH, SEQ, D), jnp.float32),
        "c": jax.random.normal(ks[1], (BATCH, D), jnp.float32),
        "w_mod": w(ks[2], (L, D, N_MOD * D), D) * 0.5,
        "b_mod": 0.02 * jax.random.normal(ks[3], (L, N_MOD * D), jnp.float32),
        "norm_ffn1": gain(ks[4], (L, D)),
        "ffn1_gate": w(ks[5], (L, D, D_FF), D),
        "ffn1_up": w(ks[6], (L, D, D_FF), D),
        "ffn1_down": w(ks[7], (L, D_FF, D), D_FF),
        "norm_mix": gain(ks[8], (L, D)),
        "w_in": w(ks[9], (L, D, D_IN), D),
        "q_norm": gain(ks[10], (L, MLA_Q_RANK)),
        "kv_norm": gain(ks[11], (L, MLA_KV_RANK)),
        "w_uq": w(ks[12], (L, MLA_Q_RANK, MLA_HEADS * (MLA_NOPE + MLA_ROPE)), MLA_Q_RANK),
        "w_ukv": w(ks[13], (L, MLA_KV_RANK, MLA_HEADS * (MLA_NOPE + MLA_V)), MLA_KV_RANK),
        "sinks": 0.5 * jax.random.normal(ks[14], (L, SWA_HEADS), jnp.float32),
        "w_o": w(ks[15], (L, MIX_OUT, D), MIX_OUT),
        "norm_ffn2": gain(ks[16], (L, D)),
        "ffn2_gate": w(ks[17], (L, D, D_FF), D),
        "ffn2_up": w(ks[18], (L, D, D_FF), D),
        "ffn2_down": w(ks[19], (L, D_FF, D), D_FF),
        "rel_bias": 0.5 * jax.random.normal(ks[20], (NUM_BUCKETS, SWA_HEADS), jnp.float32),
        "norm_final": gain(ks[21], (D,)),
    }


def reference(x, c, w_mod, b_mod, norm_ffn1, ffn1_gate, ffn1_up, ffn1_down, norm_mix, w_in,
              q_norm, kv_norm, w_uq, w_ukv, sinks, w_o, norm_ffn2, ffn2_gate, ffn2_up, ffn2_down,
              rel_bias, norm_final):
    c_act = jax.nn.silu(c)
    for l in range(DEPTH):
        mod = c_act @ w_mod[l] + b_mod[l]
        sh1, sc1, g1, sh2, sc2, g2, sh3, sc3, g3 = jnp.split(mod, N_MOD, axis=-1)

        h = modulate(rms_norm(x, norm_ffn1[l]), sh1, sc1)
        x = x + FFN_RES_WEIGHT * g1[:, None, :] * swiglu(h, ffn1_gate[l], ffn1_up[l], ffn1_down[l])

        h = modulate(rms_norm(x, norm_mix[l]), sh2, sc2)
        x = x + g2[:, None, :] * token_mixing(h, w_in[l], q_norm[l], kv_norm[l], w_uq[l], w_ukv[l],
                                              sinks[l], w_o[l], rel_bias)

        h = modulate(rms_norm(x, norm_ffn2[l]), sh3, sc3)
        x = x + FFN_RES_WEIGHT * g3[:, None, :] * swiglu(h, ffn2_gate[l], ffn2_up[l], ffn2_down[l])
    return rms_norm(x, norm_final)
```

```cpp
#include <hip/hip_runtime.h>
#include <hip/hip_cooperative_groups.h>
#include <cstdio>
#include <cstdint>
namespace cg = cooperative_groups;

namespace pg8 {
#define PG8_LAS __attribute__((address_space(3)))
typedef unsigned short bf16_t;
typedef short bf16x8 __attribute__((ext_vector_type(8)));
typedef float f32x4 __attribute__((ext_vector_type(4)));
typedef unsigned u32x4 __attribute__((ext_vector_type(4)));
constexpr int BM = 256, BK = 64, HALF = 128, HTB = HALF * BK * 2  , STAGE_BYTES = 8 * HTB, NXCD = 8, WGM = 8;

__host__ __device__ __forceinline__ int lds_byte(int r, int c) { const int st = (r >> 4) * 2 + (c >> 5), rr = r & 15, cc = c & 31, ob = rr * 64 + cc * 2; return st * 1024 + (ob ^ (((ob >> 9) & 1) << 5)); }
__host__ __device__ __forceinline__ void stage_rc(int b, int& R, int& C) { const int st = b / 1024, sb = b % 1024, swz = sb ^ (((sb >> 9) & 1) << 5); R = (st >> 1) * 16 + swz / 64; C = (st & 1) * 32 + (swz % 64) / 2; }
__host__ __device__ __forceinline__ int perm32(int rho) { const int n = rho >> 4, i = rho & 15; return 8 * (i >> 2) + 4 * n + (i & 3); }

struct Unit { int pm, pn; };
struct Gemm { const bf16_t* A; const bf16_t* Bt; int M, N, K; };

struct StaticOrder {
    int nM, nN, nwg, G, c;
    __host__ __device__ void init(int M, int N, int G_, int c_) { nM = M / BM; nN = N / BM; nwg = nM * nN; G = G_; c = c_; }
    __host__ __device__ bool next(int i, Unit& u) const {
        const long L = (long)i * G + c; if (L >= nwg) return false;
        int wgid = (int)L; { const int q = nwg / NXCD, r = nwg % NXCD, xcd = wgid % NXCD, off = wgid / NXCD; wgid = (xcd < r ? xcd * (q + 1) : r * (q + 1) + (xcd - r) * q) + off; }
        const int nig = WGM * nN, gid = wgid / nig, fm = gid * WGM, gsz = (nM - fm) < WGM ? (nM - fm) : WGM;
        u.pm = fm + ((wgid % nig) % gsz); u.pn = (wgid % nig) / gsz; return true;
    }
    __device__ __forceinline__ void a_ready(const Unit&) const {}
    __device__ __forceinline__ void done(const Unit&) const {}
};

__device__ __forceinline__ unsigned cvt_pk_bf16(float lo, float hi) { unsigned r; asm volatile("v_cvt_pk_bf16_f32 %0, %1, %2" : "=v"(r) : "v"(lo), "v"(hi)); return r; }

struct EpiBf16 {
    static constexpr bool PERM = true, AFTER_DRAIN = false;
    bf16_t* O; int ldc;
    __device__ __forceinline__ void operator()(const f32x4 (&acc)[2][2][4][2], const Unit& u, int wr, int wc, int fr, int fq) const {
        const int row0 = u.pm * BM + wr * 64 + fr; const int col0 = u.pn * BM + wc * 32 + 8 * fq;
#pragma unroll
        for (int ai = 0; ai < 2; ++ai)
#pragma unroll
            for (int m = 0; m < 4; ++m) { bf16_t* rowp = O + (size_t)(row0 + ai * HALF + m * 16) * ldc + col0;
#pragma unroll
                for (int bj = 0; bj < 2; ++bj) { const f32x4 v0 = acc[ai][bj][m][0], v1 = acc[ai][bj][m][1];
                    u32x4 w; w.x = cvt_pk_bf16(v0[0], v0[1]); w.y = cvt_pk_bf16(v0[2], v0[3]); w.z = cvt_pk_bf16(v1[0], v1[1]); w.w = cvt_pk_bf16(v1[2], v1[3]);
                    *(u32x4*)(rowp + bj * HALF) = w; } }
    }
};
__device__ __forceinline__ float silu_f(float x) { return x * __builtin_amdgcn_rcpf(1.0f + __expf(-x)); }
struct EpiSwiglu {
    static constexpr bool PERM = true, AFTER_DRAIN = false;
    bf16_t* O; int ldc;
    __device__ __forceinline__ void operator()(const f32x4 (&acc)[2][2][4][2], const Unit& u, int wr, int wc, int fr, int fq) const {
        const int row0 = u.pm * BM + wr * 64 + fr; const int col0 = u.pn * HALF + wc * 32 + 8 * fq;
#pragma unroll
        for (int ai = 0; ai < 2; ++ai)
#pragma unroll
            for (int m = 0; m < 4; ++m) { bf16_t* rowp = O + (size_t)(row0 + ai * HALF + m * 16) * ldc + col0;
                const f32x4 g0 = acc[ai][0][m][0], g1 = acc[ai][0][m][1], u0 = acc[ai][1][m][0], u1 = acc[ai][1][m][1];
                float a[8];
#pragma unroll
                for (int j = 0; j < 4; ++j) { a[j] = silu_f(g0[j]) * u0[j]; a[4 + j] = silu_f(g1[j]) * u1[j]; }
                u32x4 w; w.x = cvt_pk_bf16(a[0], a[1]); w.y = cvt_pk_bf16(a[2], a[3]); w.z = cvt_pk_bf16(a[4], a[5]); w.w = cvt_pk_bf16(a[6], a[7]);
                *(u32x4*)rowp = w; }
    }
};
struct EpiResid {
    static constexpr bool PERM = false, AFTER_DRAIN = false;
    const float* base; float* out; const float* gate; float coef;
    __device__ __forceinline__ void operator()(const f32x4 (&acc)[2][2][4][2], const Unit& u, int wr, int wc, int fr, int fq) const {
        const int row0 = u.pm * BM + wr * 64 + fr; const int col0 = u.pn * BM + wc * 32 + 4 * fq;
        const float* grow = gate + (size_t)(u.pm >> 3) * 9216 + col0;
#pragma unroll
        for (int bj = 0; bj < 2; ++bj)
#pragma unroll
            for (int n = 0; n < 2; ++n) { const f32x4 gv = *(const f32x4*)(grow + bj * HALF + n * 16) * coef;
#pragma unroll
                for (int ai = 0; ai < 2; ++ai)
#pragma unroll
                    for (int m = 0; m < 4; ++m) { const size_t off = (size_t)(row0 + ai * HALF + m * 16) * 1024 + col0 + bj * HALF + n * 16;
                        const f32x4 bs = *(const f32x4*)(base + off); *(f32x4*)(out + off) = bs + gv * acc[ai][bj][m][n]; } }
    }
};
struct EpiQRope {
    static constexpr bool PERM = true, AFTER_DRAIN = false;
    bf16_t* O; int ldc; const float* cs; float qscale;
    __device__ __forceinline__ void operator()(const f32x4 (&acc)[2][2][4][2], const Unit& u, int wr, int wc, int fr, int fq) const {
        const int row0 = u.pm * BM + wr * 64 + fr;
#pragma unroll
        for (int bj = 0; bj < 2; ++bj) { const int col0 = u.pn * BM + bj * HALF + wc * 32 + 8 * fq; const int off = col0 % 192; const bool rope = off >= 128; const int g = rope ? ((off - 128) >> 3) : 0;
#pragma unroll
            for (int ai = 0; ai < 2; ++ai)
#pragma unroll
                for (int m = 0; m < 4; ++m) { const int row = row0 + ai * HALF + m * 16; f32x4 v0 = acc[ai][bj][m][0], v1 = acc[ai][bj][m][1];
                    const float* c = cs + ((size_t)(row & 2047) * 32 + 4 * g) * 2; f32x4 c01 = *(const f32x4*)c, c23 = *(const f32x4*)(c + 4);
                    if (!rope) { c01 = (f32x4){1.f, 0.f, 1.f, 0.f}; c23 = c01; }
                    const float co[4] = {c01[0], c01[2], c23[0], c23[2]}, si[4] = {c01[1], c01[3], c23[1], c23[3]};
#pragma unroll
                    for (int j = 0; j < 4; ++j) { const float x1 = v0[j], x2 = v1[j]; v0[j] = (x1 * co[j] - x2 * si[j]) * qscale; v1[j] = (x2 * co[j] + x1 * si[j]) * qscale; }
                    u32x4 w; w.x = cvt_pk_bf16(v0[0], v0[1]); w.y = cvt_pk_bf16(v0[2], v0[3]); w.z = cvt_pk_bf16(v1[0], v1[1]); w.w = cvt_pk_bf16(v1[2], v1[3]);
                    *(u32x4*)(O + (size_t)row * ldc + col0) = w;
                    asm volatile("" ::: "memory"); } }
    }
};

template <class Epi, class Sched, bool ALIGN_EPI = false, bool SP2 = false>
__device__ __forceinline__ void gemm_phase(PG8_LAS unsigned char* lds, const Gemm g, const Sched& S, const Epi& E) {
    const int tid = threadIdx.x, wid = __builtin_amdgcn_readfirstlane(tid >> 6), lane = tid & 63, wr = wid >> 2, wc = wid & 3, fr = lane & 15, fq = lane >> 4;
    int Kop = g.K; asm volatile("" : "+s"(Kop));
    const int K = Kop, nt = K / BK;
    unsigned voffA[2], voffB[2];
#pragma unroll
    for (int i = 0; i < 2; ++i) { int R, C; stage_rc(tid * 16 + i * 8192, R, C); const int Rb = Epi::PERM ? ((R & ~31) + perm32(R & 31)) : R;
        voffA[i] = (unsigned)(R * K + C) * 2u; voffB[i] = (unsigned)(Rb * K + C) * 2u; }
    const size_t kstep = (size_t)(BK * 2);
    const size_t hstep = (size_t)HALF * K * 2;
    const size_t tstep = 2 * hstep;
    const unsigned ldsw = (unsigned)wid * 1024u;
    const int aoff = lds_byte(wr * 64 + fr, fq * 8), boff = lds_byte(wc * 32 + fr, fq * 8);
#define PG8_SA(b, h) (((b) * 2 + (h)) * HTB)
#define PG8_SB(b, h) ((4 + (b) * 2 + (h)) * HTB)
#define PG8_STAGE(bufoff, gbase, voff) do { _Pragma("unroll") for (int _i = 0; _i < 2; ++_i) \
        __builtin_amdgcn_global_load_lds((const unsigned*)((const char*)(gbase) + (voff)[_i]), (PG8_LAS unsigned*)(lds + (bufoff) + ldsw + _i * 8192), 16, 0, 0); } while (0)
#define PG8_LDA(dst, b, h) do { _Pragma("unroll") for (int m = 0; m < 4; ++m) _Pragma("unroll") for (int k = 0; k < 2; ++k) dst[m][k] = *(const PG8_LAS bf16x8*)(lds + PG8_SA(b, h) + aoff + m * 2048 + k * 1024); } while (0)
#define PG8_LDB(dst, b, h) do { _Pragma("unroll") for (int n = 0; n < 2; ++n) _Pragma("unroll") for (int k = 0; k < 2; ++k) dst[n][k] = *(const PG8_LAS bf16x8*)(lds + PG8_SB(b, h) + boff + n * 2048 + k * 1024); } while (0)
#define PG8_MMA(ai, bj, At, Bt) do { __builtin_amdgcn_s_setprio(1); _Pragma("unroll") for (int m = 0; m < 4; ++m) _Pragma("unroll") for (int n = 0; n < 2; ++n) _Pragma("unroll") for (int k = 0; k < 2; ++k) \
        acc[ai][bj][m][n] = __builtin_amdgcn_mfma_f32_16x16x32_bf16(Bt[n][k], At[m][k], acc[ai][bj][m][n], 0, 0, 0); __builtin_amdgcn_s_setprio(0); } while (0)
#define PG8_WAIT_V(n) asm volatile("s_waitcnt vmcnt(" #n ")" ::: "memory")
#define PG8_WAIT_L(n) asm volatile("s_waitcnt lgkmcnt(" #n ")" ::: "memory")
#define PG8_BAR __builtin_amdgcn_s_barrier()
#define PG8_SCHED __builtin_amdgcn_sched_barrier(0)
    Unit cur, nxt; int ui = 0;
    if (!S.next(0, cur)) return;
    f32x4 acc[2][2][4][2];
#pragma unroll
    for (int a = 0; a < 2; ++a)
#pragma unroll
        for (int b = 0; b < 2; ++b)
#pragma unroll
            for (int m = 0; m < 4; ++m)
#pragma unroll
                for (int n = 0; n < 2; ++n) acc[a][b][m][n] = (f32x4){0.f, 0.f, 0.f, 0.f};
    bf16x8 At[4][2], B0[2][2], B1[2][2];
    const char* cA = (const char*)g.A + (size_t)cur.pm * tstep; const char* cB = (const char*)g.Bt + (size_t)cur.pn * tstep;
    S.a_ready(cur);
    if constexpr (SP2) {
        PG8_STAGE(PG8_SB(0, 0), cB, voffB); PG8_STAGE(PG8_SB(0, 1), cB + hstep, voffB); PG8_STAGE(PG8_SA(0, 0), cA, voffA); PG8_STAGE(PG8_SA(0, 1), cA + hstep, voffA);
        if (wr == 1) PG8_BAR;
        PG8_WAIT_V(2); PG8_BAR;
        PG8_STAGE(PG8_SB(1, 0), cB + kstep, voffB); PG8_STAGE(PG8_SA(1, 0), cA + kstep, voffA); PG8_STAGE(PG8_SB(1, 1), cB + hstep + kstep, voffB);
        PG8_WAIT_V(6); PG8_BAR;
    } else {
        PG8_STAGE(PG8_SB(0, 0), cB, voffB); PG8_STAGE(PG8_SA(0, 0), cA, voffA); PG8_STAGE(PG8_SB(0, 1), cB + hstep, voffB); PG8_STAGE(PG8_SA(0, 1), cA + hstep, voffA);
        if (wr == 1) PG8_BAR;
        PG8_WAIT_V(4); PG8_BAR;
        PG8_STAGE(PG8_SB(1, 0), cB + kstep, voffB); PG8_STAGE(PG8_SA(1, 0), cA + kstep, voffA); PG8_STAGE(PG8_SB(1, 1), cB + hstep + kstep, voffB);
        PG8_WAIT_V(6); PG8_BAR;
    }
    for (;;) {
        const bool has_next = S.next(ui + 1, nxt);
        const char* nA = has_next ? (const char*)g.A + (size_t)nxt.pm * tstep : cA; const char* nB = has_next ? (const char*)g.Bt + (size_t)nxt.pn * tstep : cB;
        for (int t = 0; t < nt; t += 2) {
            const bool last = (t == nt - 2);
            const char* a1 = cA + (size_t)(t + 1) * kstep;
            const char* a2 = last ? nA : cA + (size_t)(t + 2) * kstep; const char* b2 = last ? nB : cB + (size_t)(t + 2) * kstep;
            const char* a3 = a2 + kstep; const char* b3 = b2 + kstep;
            if (last && has_next) S.a_ready(nxt);
            if constexpr (SP2) {
            PG8_LDB(B0, 0, 0); PG8_LDB(B1, 0, 1); PG8_SCHED; PG8_LDA(At, 0, 0); PG8_STAGE(PG8_SA(1, 1), a1 + hstep, voffA);
            PG8_WAIT_V(8); PG8_WAIT_L(0); PG8_BAR; PG8_MMA(0, 0, At, B0); PG8_MMA(0, 1, At, B1); PG8_BAR; PG8_SCHED;
            PG8_LDA(At, 0, 1); PG8_STAGE(PG8_SB(0, 0), b2, voffB); PG8_STAGE(PG8_SB(0, 1), b2 + hstep, voffB); PG8_STAGE(PG8_SA(0, 0), a2, voffA);
            PG8_WAIT_V(8); PG8_WAIT_L(0); PG8_BAR; PG8_MMA(1, 0, At, B0); PG8_MMA(1, 1, At, B1); PG8_BAR; PG8_SCHED;
            PG8_LDB(B0, 1, 0); PG8_LDB(B1, 1, 1); PG8_SCHED; PG8_LDA(At, 1, 0); PG8_STAGE(PG8_SA(0, 1), a2 + hstep, voffA);
            PG8_WAIT_V(8); PG8_WAIT_L(0); PG8_BAR; PG8_MMA(0, 0, At, B0); PG8_MMA(0, 1, At, B1); PG8_BAR; PG8_SCHED;
            PG8_LDA(At, 1, 1); PG8_STAGE(PG8_SB(1, 0), b3, voffB); PG8_STAGE(PG8_SB(1, 1), b3 + hstep, voffB); PG8_STAGE(PG8_SA(1, 0), a3, voffA);
            PG8_WAIT_V(8); PG8_WAIT_L(0); PG8_BAR; PG8_MMA(1, 0, At, B0); PG8_MMA(1, 1, At, B1); PG8_BAR; PG8_SCHED;
            } else {
            PG8_LDB(B0, 0, 0); PG8_SCHED; PG8_LDA(At, 0, 0); PG8_STAGE(PG8_SA(1, 1), a1 + hstep, voffA);
            PG8_WAIT_L(8); PG8_BAR; PG8_WAIT_L(0); PG8_MMA(0, 0, At, B0); PG8_BAR; PG8_SCHED;
            PG8_LDB(B1, 0, 1); PG8_STAGE(PG8_SB(0, 0), b2, voffB);
            PG8_BAR; PG8_WAIT_L(0); PG8_MMA(0, 1, At, B1); PG8_BAR;
            PG8_LDA(At, 0, 1); PG8_STAGE(PG8_SA(0, 0), a2, voffA);
            PG8_BAR; PG8_WAIT_L(0); PG8_MMA(1, 0, At, B0); PG8_BAR; PG8_SCHED;
            PG8_STAGE(PG8_SB(0, 1), b2 + hstep, voffB);
            PG8_WAIT_V(6); PG8_BAR; PG8_MMA(1, 1, At, B1); PG8_BAR;
            PG8_LDB(B0, 1, 0); PG8_SCHED; PG8_LDA(At, 1, 0); PG8_STAGE(PG8_SA(0, 1), a2 + hstep, voffA);
            PG8_WAIT_L(8); PG8_BAR; PG8_WAIT_L(0); PG8_MMA(0, 0, At, B0); PG8_BAR; PG8_SCHED;
            PG8_LDB(B1, 1, 1); PG8_STAGE(PG8_SB(1, 0), b3, voffB);
            PG8_BAR; PG8_WAIT_L(0); PG8_MMA(0, 1, At, B1); PG8_BAR;
            PG8_LDA(At, 1, 1); PG8_STAGE(PG8_SA(1, 0), a3, voffA);
            PG8_BAR; PG8_WAIT_L(0); PG8_MMA(1, 0, At, B0); PG8_BAR; PG8_SCHED;
            PG8_STAGE(PG8_SB(1, 1), b3 + hstep, voffB);
            PG8_WAIT_V(6); PG8_BAR; PG8_MMA(1, 1, At, B1); PG8_BAR;
            }
        }
        if constexpr (ALIGN_EPI) { if (wr == 0) PG8_BAR; }
        E(acc, cur, wr, wc, fr, fq); S.done(cur);
        if (!has_next) break;
#pragma unroll
        for (int a = 0; a < 2; ++a)
#pragma unroll
            for (int b = 0; b < 2; ++b)
#pragma unroll
                for (int m = 0; m < 4; ++m)
#pragma unroll
                    for (int n = 0; n < 2; ++n) acc[a][b][m][n] = (f32x4){0.f, 0.f, 0.f, 0.f};
        cur = nxt; cA = nA; cB = nB; ++ui;
        if constexpr (ALIGN_EPI) { if (wr == 1) PG8_BAR; }
    }
    PG8_WAIT_V(0);
    if constexpr (!ALIGN_EPI) { if (wr == 0) PG8_BAR; }
    PG8_BAR;
#undef PG8_SA
#undef PG8_SB
#undef PG8_STAGE
#undef PG8_LDA
#undef PG8_LDB
#undef PG8_MMA
#undef PG8_WAIT_V
#undef PG8_WAIT_L
#undef PG8_BAR
#undef PG8_SCHED
}
}

namespace att {
#define ATT_LAS __attribute__((address_space(3)))
typedef unsigned short bf16_t;
typedef short bf16x8 __attribute__((ext_vector_type(8)));
typedef short s16x4 __attribute__((ext_vector_type(4)));
typedef float f32x16 __attribute__((ext_vector_type(16)));
typedef unsigned u32x4 __attribute__((ext_vector_type(4)));
#define ATT_SBAR() __builtin_amdgcn_sched_barrier(0)
__device__ __forceinline__ int crow(int r, int hi) { return (r & 3) + 8 * (r >> 2) + 4 * hi; }
__device__ __forceinline__ unsigned cvtpk(float lo, float hi) { unsigned r; asm volatile("v_cvt_pk_bf16_f32 %0, %1, %2" : "=v"(r) : "v"(lo), "v"(hi)); return r; }
template <int D> __device__ __forceinline__ int kswz(int row, int chunk) { return row * (D * 2) + ((chunk * 16) ^ ((row & 7) << 4)); }
template <int NCB> __device__ __forceinline__ int v_st(int k, int c) { const int kk = (k & ~0xC) | ((k & 4) << 1) | ((k & 8) >> 1); return ((kk >> 3) * NCB + (c >> 5)) * 512 + ((kk & 7) * 32 + (c & 31)) * 2; }
__device__ __forceinline__ int v_rd_base(int lane) { return ((lane & 3) << 3) | (((lane >> 2) & 3) << 6) | (((lane >> 4) & 1) << 5) | (((lane >> 5) & 1) << 8); }

template <int DN, int DR, int DV, bool SWA>
struct Body {
    static constexpr int KN_B = 64 * DN * 2, KR_B = 64 * DR * 2, V_B = 64 * DV * 2, K_B = KN_B + KR_B, BUF_B = K_B + V_B;
    static constexpr int NCB = DV / 32, GS = NCB * 512;
    static constexpr int NQ = (DN + DR) / 16;
    static constexpr int NCH_KN = 64 * DN / 8 / 512, NCH_KR = (DR > 0) ? 1 : 0, NCH_V = 64 * DV / 8 / 512;
    static constexpr int OFF_SCR = 2 * BUF_B, OFF_BIAS = OFF_SCR + 8 * 256, LDS_TOTAL = OFF_BIAS + 384 * 4;
    static_assert(DR == 0 || DR == 64, "rope dims");

    struct Stage { bf16x8 kn[NCH_KN]; bf16x8 kr[NCH_KR ? NCH_KR : 1]; bf16x8 v[NCH_V]; };

    __device__ static __forceinline__ void stage_load(Stage& S, const bf16_t* KN, int knp, const bf16_t* KR, int krp, const bf16_t* V, int vp, int kb, int tid) {
#pragma unroll
        for (int i = 0; i < NCH_KN; ++i) { const int ci = tid + 512 * i, row = ci / (DN / 8), ch = ci % (DN / 8); S.kn[i] = *(const bf16x8*)(KN + (size_t)(kb + row) * knp + ch * 8); }
        if constexpr (DR > 0) { const int row = tid >> 3, ch = tid & 7; S.kr[0] = *(const bf16x8*)(KR + (size_t)(kb + row) * krp + ch * 8); }
#pragma unroll
        for (int i = 0; i < NCH_V; ++i) { const int ci = tid + 512 * i, row = ci / (DV / 8), ch = ci % (DV / 8); S.v[i] = *(const bf16x8*)(V + (size_t)(kb + row) * vp + ch * 8); }
    }
    __device__ static __forceinline__ void stage_write(const Stage& S, ATT_LAS char* lds, int cur, int tid) {
        ATT_LAS char* kbuf = lds + 2 * V_B + cur * K_B; ATT_LAS char* vbuf = lds + cur * V_B;
#pragma unroll
        for (int i = 0; i < NCH_KN; ++i) { const int ci = tid + 512 * i, row = ci / (DN / 8), ch = ci % (DN / 8); *(ATT_LAS bf16x8*)(kbuf + kswz<DN>(row, ch)) = S.kn[i]; }
        if constexpr (DR > 0) { const int row = tid >> 3, ch = tid & 7; *(ATT_LAS bf16x8*)(kbuf + KN_B + kswz<64>(row, ch)) = S.kr[0]; }
#pragma unroll
        for (int i = 0; i < NCH_V; ++i) { const int ci = tid + 512 * i, row = ci / (DV / 8), ch = ci % (DV / 8); *(ATT_LAS bf16x8*)(vbuf + v_st<NCB>(row, ch * 8)) = S.v[i]; }
    }
    template <int D> __device__ static __forceinline__ void qk_acc(f32x16& p0, f32x16& p1, const ATT_LAS char* Kt, int r32, int hi, const bf16x8* qr) {
        const ATT_LAS char* kb[4];
#pragma unroll
        for (int dd = 0; dd < 4; ++dd) kb[dd] = Kt + kswz<D>(r32, 2 * dd + hi);
#pragma unroll
        for (int d0 = 0; d0 < D / 16; ++d0) { const ATT_LAS char* a = kb[d0 & 3] + (d0 >> 2) * 128;
            const bf16x8 b0 = *(const ATT_LAS bf16x8*)a; const bf16x8 b1 = *(const ATT_LAS bf16x8*)(a + 32 * D * 2);
            p0 = __builtin_amdgcn_mfma_f32_32x32x16_bf16(b0, qr[d0], p0, 0, 0, 0);
            p1 = __builtin_amdgcn_mfma_f32_32x32x16_bf16(b1, qr[d0], p1, 0, 0, 0); }
    }
    template <int VOFF> __device__ static __forceinline__ void pv_tile(f32x16* o, int vaddr, bf16x8 pa0, bf16x8 pa1, bf16x8 pa2, bf16x8 pa3) {
#define ATT_TRRD(dst, off) asm volatile("ds_read_b64_tr_b16 %0, %1 offset:%2" : "=&v"(dst) : "v"(vaddr), "i"(off) : "memory")
#pragma unroll
        for (int d0 = 0; d0 < NCB; ++d0) { s16x4 l0, l1, l2, l3, h0, h1, h2, h3; const int b_ = VOFF + d0 * 512;
            ATT_TRRD(l0, b_); ATT_TRRD(h0, b_ + GS); ATT_TRRD(l1, b_ + 2 * GS); ATT_TRRD(h1, b_ + 3 * GS); ATT_TRRD(l2, b_ + 4 * GS); ATT_TRRD(h2, b_ + 5 * GS); ATT_TRRD(l3, b_ + 6 * GS); ATT_TRRD(h3, b_ + 7 * GS);
            asm volatile("s_waitcnt lgkmcnt(0)" ::: "memory"); ATT_SBAR();
            o[d0] = __builtin_amdgcn_mfma_f32_32x32x16_bf16(pa0, (bf16x8){l0[0], l0[1], l0[2], l0[3], h0[0], h0[1], h0[2], h0[3]}, o[d0], 0, 0, 0);
            o[d0] = __builtin_amdgcn_mfma_f32_32x32x16_bf16(pa1, (bf16x8){l1[0], l1[1], l1[2], l1[3], h1[0], h1[1], h1[2], h1[3]}, o[d0], 0, 0, 0);
            o[d0] = __builtin_amdgcn_mfma_f32_32x32x16_bf16(pa2, (bf16x8){l2[0], l2[1], l2[2], l2[3], h2[0], h2[1], h2[2], h2[3]}, o[d0], 0, 0, 0);
            o[d0] = __builtin_amdgcn_mfma_f32_32x32x16_bf16(pa3, (bf16x8){l3[0], l3[1], l3[2], l3[3], h3[0], h3[1], h3[2], h3[3]}, o[d0], 0, 0, 0); }
#undef ATT_TRRD
    }

    struct State { bf16x8 qr[NQ]; f32x16 o[NCB]; float m, l; };

    template <int CUR> __device__ static __forceinline__ void tile(State& st, ATT_LAS char* lds, int ldsaddr, int r32, int hi, int wid, int dq, unsigned W, bool needmask, float scl) {
        const ATT_LAS char* buf = lds + 2 * V_B + CUR * K_B;
        f32x16 p0 = {}, p1 = {};
        qk_acc<DN>(p0, p1, buf, r32, hi, st.qr);
        if constexpr (DR > 0) qk_acc<DR>(p0, p1, buf + KN_B, r32, hi, st.qr + DN / 16);
        if constexpr (SWA) {
            const ATT_LAS float* tl = (const ATT_LAS float*)(lds + OFF_BIAS) + (256 - dq);
#pragma unroll
            for (int r = 0; r < 16; ++r) { const int c = (r & 3) + 8 * (r >> 2); p0[r] = fmaf(p0[r], scl, tl[c]); p1[r] = fmaf(p1[r], scl, tl[c + 32]); }
        }
        if (needmask) { const float NEG = -__builtin_inff();
#pragma unroll
            for (int r = 0; r < 16; ++r) { const int c = (r & 3) + 8 * (r >> 2);
                if ((unsigned)(dq - c) >= W) p0[r] = NEG;
                if ((unsigned)(dq - c - 32) >= W) p1[r] = NEG; } }
        float pmax = p0[0];
#pragma unroll
        for (int r = 1; r < 16; ++r) pmax = fmaxf(pmax, p0[r]);
#pragma unroll
        for (int r = 0; r < 16; ++r) pmax = fmaxf(pmax, p1[r]);
        { auto rr = __builtin_amdgcn_permlane32_swap(__float_as_uint(pmax), __float_as_uint(pmax), false, false); pmax = fmaxf(__uint_as_float(rr[0]), __uint_as_float(rr[1])); }
        const float mn = fmaxf(st.m, pmax); const float alpha = __builtin_amdgcn_exp2f(st.m - mn); st.m = mn;
        float ps = 0.f;
#pragma unroll
        for (int r = 0; r < 16; ++r) { p0[r] = __builtin_amdgcn_exp2f(p0[r] - mn); p1[r] = __builtin_amdgcn_exp2f(p1[r] - mn); ps += p0[r] + p1[r]; }
        { auto rr = __builtin_amdgcn_permlane32_swap(__float_as_uint(ps), __float_as_uint(ps), false, false); ps = __uint_as_float(rr[0]) + __uint_as_float(rr[1]); }
        st.l = st.l * alpha + ps;
        bf16x8 pa0, pa1, pa2, pa3;
#define ATT_PK4(P, B_, OUT) do { unsigned a0 = cvtpk(P[B_ + 0], P[B_ + 1]), a1 = cvtpk(P[B_ + 2], P[B_ + 3]); unsigned b0 = cvtpk(P[B_ + 4], P[B_ + 5]), b1 = cvtpk(P[B_ + 6], P[B_ + 7]); \
        auto r0 = __builtin_amdgcn_permlane32_swap(a0, b0, false, false); auto r1 = __builtin_amdgcn_permlane32_swap(a1, b1, false, false); \
        u32x4 w = {r0[0], r1[0], r0[1], r1[1]}; OUT = *reinterpret_cast<bf16x8*>(&w); } while (0)
        ATT_PK4(p0, 0, pa0); ATT_PK4(p0, 8, pa1); ATT_PK4(p1, 0, pa2); ATT_PK4(p1, 8, pa3);
#undef ATT_PK4
        if (__any(alpha < 1.f)) { ATT_LAS float* al = (ATT_LAS float*)(lds + OFF_SCR) + wid * 64;
            if (hi == 0) al[r32] = alpha;
            asm volatile("s_waitcnt lgkmcnt(0)" ::: "memory");
#pragma unroll
            for (int r = 0; r < 16; ++r) { const float a = al[crow(r, hi)];
#pragma unroll
                for (int d0 = 0; d0 < NCB; ++d0) st.o[d0][r] *= a; }
            asm volatile("s_waitcnt lgkmcnt(0)" ::: "memory"); }
        ATT_SBAR();
        pv_tile<CUR * V_B>(st.o, ldsaddr, pa0, pa1, pa2, pa3);
    }

    __device__ static __forceinline__ void unit(ATT_LAS char* lds, const bf16_t* Qrow, int qpitch, const bf16_t* KN, int knp, const bf16_t* KR, int krp, const bf16_t* V, int vp,
                                                bf16_t* Orow, int opitch, int r0, int kb0, int NT, unsigned W, float scl, float sinkl2) {
        const int tid = threadIdx.x, lane = tid & 63, r32 = lane & 31, hi = lane >> 5; const int wid = __builtin_amdgcn_readfirstlane(tid >> 6);
        const int ldsaddr = (int)(unsigned)(uintptr_t)lds + v_rd_base(lane);
        State st;
#pragma unroll
        for (int d0 = 0; d0 < NQ; ++d0) st.qr[d0] = *(const bf16x8*)(Qrow + (size_t)r32 * qpitch + d0 * 16 + hi * 8);
#pragma unroll
        for (int d0 = 0; d0 < NCB; ++d0) st.o[d0] = f32x16{};
        st.m = -1e30f; st.l = 0.f;
        Stage sg;
        stage_load(sg, KN, knp, KR, krp, V, vp, kb0, tid);
        stage_write(sg, lds, 0, tid);
        __syncthreads();
        const int rowpos = r0 + r32;
#define ATT_STEP(CUR, t) do { const int kb_ = kb0 + 64 * (t); const bool more_ = (t) + 1 < NT; \
        if (more_) stage_load(sg, KN, knp, KR, krp, V, vp, kb_ + 64, tid); \
        const bool act_ = (kb_ <= r0 + 31) && ((long)kb_ + 63 >= (long)r0 - (long)(W - 1u)); \
        if (act_) { const bool nm_ = SWA || (kb_ + 63 > r0); tile<CUR>(st, lds, ldsaddr, r32, hi, wid, rowpos - kb_ - 4 * hi, W, nm_, scl); } \
        if (more_) stage_write(sg, lds, (CUR) ^ 1, tid); \
        __syncthreads(); } while (0)
        int t = 0;
        for (; t + 1 < NT; t += 2) { ATT_STEP(0, t); ATT_STEP(1, t + 1); }
        if (t < NT) { ATT_STEP(0, t); }
#undef ATT_STEP
        if constexpr (SWA) st.l += __builtin_amdgcn_exp2f(sinkl2 - st.m);
        ATT_LAS float* li = (ATT_LAS float*)(lds + OFF_SCR) + wid * 64 + 32;
        if (hi == 0) li[r32] = st.l;
        asm volatile("s_waitcnt lgkmcnt(0)" ::: "memory");
        float rli[16];
#pragma unroll
        for (int r = 0; r < 16; ++r) rli[r] = __builtin_amdgcn_rcpf(li[crow(r, hi)]);
#pragma unroll
        for (int r = 0; r < 16; ++r) { const int orow = crow(r, hi);
#pragma unroll
            for (int d0 = 0; d0 < NCB; ++d0) { const float v = st.o[d0][r] * rli[r]; const float vn = __shfl_xor(v, 1);
                if ((r32 & 1) == 0) *(unsigned*)(Orow + (size_t)orow * opitch + d0 * 32 + r32) = cvtpk(v, vn); } }
        __syncthreads();
    }
};
}

constexpr int D_MODEL = 1024, BATCH = 8, SEQ = 2048, M = BATCH * SEQ, D_FF = 2816, N_MOD = 9;
constexpr int D_IN = 1216, D_IN_PAD = 1280;
constexpr float EPS = 1e-6f;
constexpr float L2E = 1.4426950408889634f;
constexpr int NWAVES = 8;

constexpr size_t MiB = 1u << 20;
constexpr size_t WS_CTL = 0;
constexpr size_t WS_MOD = 1 * MiB;
constexpr size_t WS_ROPE = 2 * MiB;
constexpr size_t WS_W1GU = 4 * MiB;
constexpr size_t WS_W1D = 15 * MiB;
constexpr size_t WS_W2GU = 21 * MiB;
constexpr size_t WS_W2D = 32 * MiB;
constexpr size_t WS_WIN = 38 * MiB;
constexpr size_t WS_WO = 41 * MiB;
constexpr size_t WS_WUQ = 43 * MiB;
constexpr size_t WS_WUKV = 44 * MiB;
constexpr size_t WS_H = 46 * MiB;
constexpr size_t WS_ACT = 78 * MiB;
constexpr size_t WS_PROJ = 78 * MiB;
constexpr size_t WS_Q = 118 * MiB;
constexpr size_t WS_KV = 142 * MiB;
constexpr size_t WS_MIX = 174 * MiB;
constexpr size_t WS_QN = 206 * MiB;
constexpr size_t WS_KVN = 214 * MiB;
constexpr size_t WS_KR = 218 * MiB;
constexpr size_t WS_END = 220 * MiB;

constexpr int LDS_BYTES = 147456;

typedef unsigned short bf16;
typedef float f32x4 __attribute__((ext_vector_type(4)));
typedef unsigned v4u __attribute__((ext_vector_type(4)));
typedef short bf16x8 __attribute__((ext_vector_type(8)));
#define LAS __attribute__((address_space(3)))

__device__ __forceinline__ unsigned f2bf(float f) { unsigned u = __builtin_bit_cast(unsigned, f); return (u + 0x7fffu + ((u >> 16) & 1u)) >> 16; }
__device__ __forceinline__ unsigned pk2(float lo, float hi) { return f2bf(lo) | (f2bf(hi) << 16); }
__device__ __forceinline__ float bf2f(unsigned short h) { return __builtin_bit_cast(float, (unsigned)h << 16); }
__device__ __forceinline__ float wave_sum(float v) {
#pragma unroll
    for (int o = 1; o < 64; o <<= 1) v += __shfl_xor(v, o);
    return v;
}

struct Args {
    const float* in[22]; float* out; unsigned char* ws; int ph_lo, ph_hi;
};

template <class RowMap>
__device__ __forceinline__ void transpose_item(const float* W, int K, int N, bf16* WT, LAS float* scr, int item, int lane, RowMap rm) {
    const int nblk = N / 32, kb = item / nblk, nb = item % nblk, k0 = 64 * kb, n0 = 32 * nb;
#pragma unroll 8
    for (int i = 0; i < 32; ++i) { const int kk = 2 * i + (lane >> 5); scr[kk * 33 + (lane & 31)] = W[(size_t)(k0 + kk) * N + n0 + (lane & 31)]; }
    asm volatile("s_waitcnt lgkmcnt(0)" ::: "memory");
    const int c = lane & 7;
#pragma unroll
    for (int j = 0; j < 4; ++j) { const int n = (lane >> 3) + 8 * j; const LAS float* s = scr + (8 * c) * 33 + n;
        v4u o; o.x = pk2(s[0 * 33], s[1 * 33]); o.y = pk2(s[2 * 33], s[3 * 33]); o.z = pk2(s[4 * 33], s[5 * 33]); o.w = pk2(s[6 * 33], s[7 * 33]);
        *(v4u*)(WT + (size_t)rm(n0 + n) * K + k0 + 8 * c) = o; }
    asm volatile("s_waitcnt lgkmcnt(0)" ::: "memory");
}
struct RmId { __device__ __forceinline__ int operator()(int n) const { return n; } };
struct RmGU { int sel; __device__ __forceinline__ int operator()(int n) const { return (n >> 7) * 256 + sel * 128 + (n & 127); } };
struct RmUq { __device__ __forceinline__ int operator()(int n) const { const int h = n / 192, off = n % 192; if (off < 128) return n; int i = off - 128; int pos;
        if (i < 32) pos = 8 * (i >> 2) + (i & 3); else { i -= 32; pos = 8 * (i >> 2) + 4 + (i & 3); } return 192 * h + 128 + pos; } };

__device__ __forceinline__ int t5_bucket(int dist) {
    if (dist < 16) return dist;
    const float v = __logf((float)dist * (1.0f / 16.0f)) * (16.0f / 2.0794415416798357f);
    int b = 16 + (int)v; return b > 31 ? 31 : b;
}

__global__ void __launch_bounds__(NWAVES * 64, 2) fwd_kernel(Args args) {
    extern __shared__ __attribute__((aligned(16))) unsigned char lds_raw[];
    LAS unsigned char* lds = (LAS unsigned char*)lds_raw;
    cg::grid_group grid = cg::this_grid();
    const int tid = threadIdx.x, lane = tid & 63, wave = __builtin_amdgcn_readfirstlane(tid >> 6);
    const int G = gridDim.x, bx = blockIdx.x;
    const int vcu = (G % 8 == 0) ? (bx % 8) * (G / 8) + bx / 8 : bx;
    const int gw = vcu * NWAVES + wave, NGW = G * NWAVES;
    unsigned char* ws = args.ws;
    const float* x_in = args.in[0]; const float* c_in = args.in[1]; const float* w_mod = args.in[2]; const float* b_mod = args.in[3];
    const float* norm_ffn1 = args.in[4]; const float* ffn1_gate = args.in[5]; const float* ffn1_up = args.in[6]; const float* ffn1_down = args.in[7];
    const float* norm_mix = args.in[8]; const float* w_in = args.in[9]; const float* q_norm = args.in[10]; const float* kv_norm = args.in[11];
    const float* w_uq = args.in[12]; const float* w_ukv = args.in[13]; const float* sinks = args.in[14]; const float* w_o = args.in[15];
    const float* norm_ffn2 = args.in[16]; const float* ffn2_gate = args.in[17]; const float* ffn2_up = args.in[18]; const float* ffn2_down = args.in[19];
    const float* rel_bias = args.in[20]; const float* norm_final = args.in[21];
    float* X = args.out;
    float* MOD = (float*)(ws + WS_MOD); float* ROPE = (float*)(ws + WS_ROPE);
    bf16* W1GU = (bf16*)(ws + WS_W1GU); bf16* W1D = (bf16*)(ws + WS_W1D); bf16* W2GU = (bf16*)(ws + WS_W2GU); bf16* W2D = (bf16*)(ws + WS_W2D);
    bf16* WIN = (bf16*)(ws + WS_WIN); bf16* WO = (bf16*)(ws + WS_WO); bf16* WUQ = (bf16*)(ws + WS_WUQ); bf16* WUKV = (bf16*)(ws + WS_WUKV);
    bf16* H = (bf16*)(ws + WS_H); bf16* ACT = (bf16*)(ws + WS_ACT); bf16* PROJ = (bf16*)(ws + WS_PROJ); bf16* Qb = (bf16*)(ws + WS_Q);
    bf16* KV = (bf16*)(ws + WS_KV); bf16* MIX = (bf16*)(ws + WS_MIX); bf16* QN = (bf16*)(ws + WS_QN); bf16* KVN = (bf16*)(ws + WS_KVN); bf16* KR = (bf16*)(ws + WS_KR);

    const int lo = args.ph_lo, hi = args.ph_hi;
#ifndef PH_MASK
#define PH_MASK 0xFFFFFFFFu
#endif
#define IN(k) (((PH_MASK >> (k)) & 1u) && lo <= (k) && (k) < hi)
#define SEAM(k) do { if (IN(k) && IN((k) + 1)) grid.sync(); } while (0)

    if (IN(0)) {
        for (int u = bx; u < (N_MOD * D_MODEL) / 64; u += G) {
            LAS float* sact = (LAS float*)lds;
            LAS float* part = (LAS float*)(lds + 32768);
            for (int i = tid; i < BATCH * D_MODEL; i += NWAVES * 64) { const float v = c_in[i]; sact[i] = v / (1.0f + __expf(-v)); }
            __syncthreads();
            const int n = 64 * u + lane; float acc[8];
#pragma unroll
            for (int b = 0; b < 8; ++b) acc[b] = 0.f;
            const float* wp = w_mod + (size_t)(128 * wave) * (N_MOD * D_MODEL) + n;
#pragma unroll 8
            for (int k = 0; k < 128; ++k) { const float wv = wp[(size_t)k * (N_MOD * D_MODEL)];
#pragma unroll
                for (int b = 0; b < 8; ++b) acc[b] = fmaf(sact[b * 1024 + 128 * wave + k], wv, acc[b]); }
#pragma unroll
            for (int b = 0; b < 8; ++b) part[(wave * 8 + b) * 64 + lane] = acc[b];
            __syncthreads();
            { const int b = tid >> 6; float s = 0.f;
#pragma unroll
              for (int w = 0; w < 8; ++w) s += part[(w * 8 + b) * 64 + lane];
              MOD[(size_t)b * (N_MOD * D_MODEL) + n] = s + b_mod[n]; }
            __syncthreads();
        }
        for (int idx = bx * (NWAVES * 64) + tid; idx < SEQ * 32; idx += G * NWAVES * 64) { const int p = idx >> 5, i = idx & 31;
            const float inv = powf(10000.0f, -(float)(2 * i) / 64.0f); const float ang = (float)p * inv;
            ROPE[2 * idx] = cosf(ang); ROPE[2 * idx + 1] = sinf(ang); }
        LAS float* scr = (LAS float*)(lds + wave * 16384);
        constexpr int I_GU = (D_MODEL / 64) * (D_FF / 32), I_D = (D_FF / 64) * (D_MODEL / 32), I_IN = (D_MODEL / 64) * (D_IN / 32), I_O = (D_MODEL / 64) * (D_MODEL / 32),
                      I_UQ = (256 / 64) * (768 / 32), I_UKV = (128 / 64) * (1024 / 32);
        constexpr int NITEMS = 4 * I_GU + 2 * I_D + I_IN + I_O + I_UQ + I_UKV;
        for (int it = gw; it < NITEMS; it += NGW) {
            int r = it;
            if (r < I_GU) { transpose_item(ffn1_gate, D_MODEL, D_FF, W1GU, scr, r, lane, RmGU{0}); continue; } r -= I_GU;
            if (r < I_GU) { transpose_item(ffn1_up, D_MODEL, D_FF, W1GU, scr, r, lane, RmGU{1}); continue; } r -= I_GU;
            if (r < I_GU) { transpose_item(ffn2_gate, D_MODEL, D_FF, W2GU, scr, r, lane, RmGU{0}); continue; } r -= I_GU;
            if (r < I_GU) { transpose_item(ffn2_up, D_MODEL, D_FF, W2GU, scr, r, lane, RmGU{1}); continue; } r -= I_GU;
            if (r < I_D) { transpose_item(ffn1_down, D_FF, D_MODEL, W1D, scr, r, lane, RmId{}); continue; } r -= I_D;
            if (r < I_D) { transpose_item(ffn2_down, D_FF, D_MODEL, W2D, scr, r, lane, RmId{}); continue; } r -= I_D;
            if (r < I_IN) { transpose_item(w_in, D_MODEL, D_IN, WIN, scr, r, lane, RmId{}); continue; } r -= I_IN;
            if (r < I_O) { transpose_item(w_o, D_MODEL, D_MODEL, WO, scr, r, lane, RmId{}); continue; } r -= I_O;
            if (r < I_UQ) { transpose_item(w_uq, 256, 768, WUQ, scr, r, lane, RmUq{}); continue; } r -= I_UQ;
            transpose_item(w_ukv, 128, 1024, WUKV, scr, r, lane, RmId{});
        }
        for (int i = bx * (NWAVES * 64) + tid; i < (D_IN_PAD - D_IN) * D_MODEL / 8; i += G * NWAVES * 64) ((v4u*)(WIN + (size_t)D_IN * D_MODEL))[i] = (v4u){0u, 0u, 0u, 0u};
    }
    SEAM(0);

    auto modnorm = [&](const float* src, const float* gain, int chunk) {
        for (int r8 = gw; r8 < M / 8; r8 += NGW) {
            const int row0 = r8 * 8, b = row0 / SEQ;
            const float* shp = MOD + (size_t)b * (N_MOD * D_MODEL) + (size_t)chunk * D_MODEL; const float* scp = shp + D_MODEL;
            f32x4 gg[4], sh[4];
#pragma unroll
            for (int j = 0; j < 4; ++j) { const f32x4 g = ((const f32x4*)gain)[lane + 64 * j], sc = ((const f32x4*)scp)[lane + 64 * j]; gg[j] = g * (1.0f + sc); sh[j] = ((const f32x4*)shp)[lane + 64 * j]; }
            for (int rr = 0; rr < 8; ++rr) { const int row = row0 + rr;
                const f32x4* xr = (const f32x4*)(src + (size_t)row * D_MODEL) + lane;
                f32x4 v[4]; float s = 0.f;
#pragma unroll
                for (int j = 0; j < 4; ++j) { v[j] = xr[64 * j]; s += (v[j].x * v[j].x + v[j].y * v[j].y) + (v[j].z * v[j].z + v[j].w * v[j].w); }
                const float rstd = 1.0f / sqrtf(wave_sum(s) * (1.0f / D_MODEL) + EPS);
                unsigned long long* o8 = (unsigned long long*)(H + (size_t)row * D_MODEL) + lane;
#pragma unroll
                for (int j = 0; j < 4; ++j) { const f32x4 y = v[j] * rstd * gg[j] + sh[j];
                    o8[64 * j] = (unsigned long long)pk2(y.x, y.y) | ((unsigned long long)pk2(y.z, y.w) << 32); } }
        }
    };

    if (IN(1)) modnorm(x_in, norm_ffn1, 0);
    SEAM(1);
    if (IN(2)) { pg8::Gemm g{H, W1GU, M, 2 * D_FF, D_MODEL}; pg8::StaticOrder S; S.init(M, 2 * D_FF, G, bx); pg8::EpiSwiglu E{ACT, D_FF};
        pg8::gemm_phase<pg8::EpiSwiglu, pg8::StaticOrder, true, true>(lds, g, S, E); }
    SEAM(2);
    if (IN(3)) { pg8::Gemm g{ACT, W1D, M, D_MODEL, D_FF}; pg8::StaticOrder S; S.init(M, D_MODEL, G, bx); pg8::EpiResid E{x_in, X, MOD + 2 * D_MODEL, 0.5f};
        pg8::gemm_phase<pg8::EpiResid, pg8::StaticOrder, true, true>(lds, g, S, E); }
    SEAM(3);
    if (IN(4)) modnorm(X, norm_mix, 3);
    SEAM(4);
    if (IN(5)) { pg8::Gemm g{H, WIN, M, D_IN_PAD, D_MODEL}; pg8::StaticOrder S; S.init(M, D_IN_PAD, G, bx); pg8::EpiBf16 E{PROJ, D_IN_PAD};
        pg8::gemm_phase<pg8::EpiBf16, pg8::StaticOrder, true, true>(lds, g, S, E); }
    SEAM(5);
    if (IN(6)) {
        const f32x4 qg = ((const f32x4*)q_norm)[lane]; const float kg0 = kv_norm[2 * lane], kg1 = kv_norm[2 * lane + 1];
        for (int row = gw; row < M; row += NGW) {
            const bf16* pr = PROJ + (size_t)row * D_IN_PAD;
            const unsigned long long qraw = ((const unsigned long long*)(pr + 768))[lane]; const unsigned kraw = ((const unsigned*)(pr + 1024))[lane]; const unsigned short rraw = pr[1152 + lane];
            const float q0 = bf2f((unsigned short)qraw), q1 = bf2f((unsigned short)(qraw >> 16)), q2 = bf2f((unsigned short)(qraw >> 32)), q3 = bf2f((unsigned short)(qraw >> 48));
            const float k0 = bf2f((unsigned short)kraw), k1 = bf2f((unsigned short)(kraw >> 16)); const float xr = bf2f(rraw);
            const float qs = wave_sum((q0 * q0 + q1 * q1) + (q2 * q2 + q3 * q3)), ks = wave_sum(k0 * k0 + k1 * k1);
            const float qr = 1.0f / sqrtf(qs * (1.0f / 256.0f) + EPS), kr = 1.0f / sqrtf(ks * (1.0f / 128.0f) + EPS);
            ((unsigned long long*)(QN + (size_t)row * 256))[lane] = (unsigned long long)pk2(q0 * qr * qg.x, q1 * qr * qg.y) | ((unsigned long long)pk2(q2 * qr * qg.z, q3 * qr * qg.w) << 32);
            ((unsigned*)(KVN + (size_t)row * 128))[lane] = pk2(k0 * kr * kg0, k1 * kr * kg1);
            const float other = __shfl_xor(xr, 32); const int i = lane & 31; const int pos = row & (SEQ - 1);
            const float co = ROPE[(pos * 32 + i) * 2], si = ROPE[(pos * 32 + i) * 2 + 1];
            const float y = (lane < 32) ? (xr * co - other * si) : (xr * co + other * si);
            const int dst = 8 * (i >> 2) + (i & 3) + ((lane < 32) ? 0 : 4);
            KR[(size_t)row * 64 + dst] = (bf16)f2bf(y);
        }
    }
    SEAM(6);
    if (IN(7)) {
#ifndef NO_QG
        { pg8::Gemm g{QN, WUQ, M, 768, 256}; pg8::StaticOrder S; S.init(M, 768, G, bx); pg8::EpiQRope E{Qb, 768, ROPE, 0.07216878364870322f * L2E};
          pg8::gemm_phase<pg8::EpiQRope, pg8::StaticOrder, true, true>(lds, g, S, E); }
#endif
#ifndef NO_KVG
        { pg8::Gemm g{KVN, WUKV, M, 1024, 128}; pg8::StaticOrder S; S.init(M, 1024, G, bx); pg8::EpiBf16 E{KV, 1024};
          pg8::gemm_phase<pg8::EpiBf16, pg8::StaticOrder, true, true>(lds, g, S, E); }
#endif
    }
    SEAM(7);
    if (IN(8)) {
        LAS char* alds = (LAS char*)lds;
        {
            typedef att::Body<128, 64, 128, false> B;
            static_assert(B::LDS_TOTAL <= LDS_BYTES, "MLA LDS");
            for (int u = vcu; u < BATCH * 4 * 8; u += G) { const int bh = u >> 3, y = 7 - (u & 7), b = bh >> 2, h = bh & 3;
                const int r0 = (wave < 4) ? (128 * y + 32 * wave) : (128 * (15 - y) + 32 * (wave - 4));
                const size_t rb = (size_t)b * SEQ;
                B::unit(alds, Qb + (rb + r0) * 768 + 192 * h, 768, KV + rb * 1024 + 256 * h, 1024, KR + rb * 64, 64, KV + rb * 1024 + 256 * h + 128, 1024,
                        MIX + (rb + r0) * 1024 + 512 + 128 * h, 1024, r0, 0, 32 - 2 * y, 0x7fffffffu, 1.0f, 0.f); }
        }
        {
            typedef att::Body<64, 0, 64, true> B;
            static_assert(B::LDS_TOTAL <= LDS_BYTES, "SWA LDS");
            for (int u = vcu; u < BATCH * 8 * 8; u += G) { const int bh = u >> 3, qb = u & 7, b = bh >> 3, h = bh & 7, gkv = h >> 2;
                LAS float* tb = (LAS float*)(alds + B::OFF_BIAS);
                if (tid < 384) { const int dist = 256 - tid; tb[tid] = (dist >= 0 && dist < 128) ? rel_bias[t5_bucket(dist) * 8 + h] * L2E : 0.f; }
                const int r0 = 256 * qb + 32 * wave; const int kb0 = qb == 0 ? 0 : 256 * qb - 128; const int NT = (256 * qb + 256 - kb0) / 64;
                const size_t rb = (size_t)b * SEQ;
                B::unit(alds, PROJ + (rb + r0) * D_IN_PAD + 64 * h, D_IN_PAD, PROJ + rb * D_IN_PAD + 512 + 64 * gkv, D_IN_PAD, nullptr, 0, PROJ + rb * D_IN_PAD + 640 + 64 * gkv, D_IN_PAD,
                        MIX + (rb + r0) * 1024 + 64 * h, 1024, r0, kb0, NT, 128u, 0.125f * L2E, sinks[h] * L2E); }
        }
    }
    SEAM(8);
    if (IN(9)) { pg8::Gemm g{MIX, WO, M, D_MODEL, D_MODEL}; pg8::StaticOrder S; S.init(M, D_MODEL, G, bx); pg8::EpiResid E{X, X, MOD + 5 * D_MODEL, 1.0f};
        pg8::gemm_phase<pg8::EpiResid, pg8::StaticOrder, true, true>(lds, g, S, E); }
    SEAM(9);
    if (IN(10)) modnorm(X, norm_ffn2, 6);
    SEAM(10);
    if (IN(11)) { pg8::Gemm g{H, W2GU, M, 2 * D_FF, D_MODEL}; pg8::StaticOrder S; S.init(M, 2 * D_FF, G, bx); pg8::EpiSwiglu E{ACT, D_FF};
        pg8::gemm_phase<pg8::EpiSwiglu, pg8::StaticOrder, true, true>(lds, g, S, E); }
    SEAM(11);
    if (IN(12)) { pg8::Gemm g{ACT, W2D, M, D_MODEL, D_FF}; pg8::StaticOrder S; S.init(M, D_MODEL, G, bx); pg8::EpiResid E{X, X, MOD + 8 * D_MODEL, 0.5f};
        pg8::gemm_phase<pg8::EpiResid, pg8::StaticOrder, true, true>(lds, g, S, E); }
    SEAM(12);
    if (IN(13)) {
        f32x4 gg[4];
#pragma unroll
        for (int j = 0; j < 4; ++j) gg[j] = ((const f32x4*)norm_final)[lane + 64 * j];
        for (int row = gw; row < M; row += NGW) { f32x4* xr = (f32x4*)(X + (size_t)row * D_MODEL) + lane; f32x4 v[4]; float s = 0.f;
#pragma unroll
            for (int j = 0; j < 4; ++j) { v[j] = xr[64 * j]; s += (v[j].x * v[j].x + v[j].y * v[j].y) + (v[j].z * v[j].z + v[j].w * v[j].w); }
            const float rstd = 1.0f / sqrtf(wave_sum(s) * (1.0f / D_MODEL) + EPS);
#pragma unroll
            for (int j = 0; j < 4; ++j) xr[64 * j] = v[j] * rstd * gg[j]; }
    }
#undef IN
#undef SEAM
}

constexpr int N_PHASES = 14;

extern "C" void kernel_launch(void* const* d_in, const int* in_sizes, int n_in, void* d_out, int out_size, void* d_ws, size_t ws_size, hipStream_t stream) {
    static int grid = 0;
    if (grid == 0) {
        if (n_in != 22 || out_size != M * D_MODEL || ws_size < WS_END) { fprintf(stderr, "kernel_launch: unexpected shapes (n_in %d out %d ws %zu)\n", n_in, out_size, ws_size); grid = -1; return; }
        int dev = 0, cus = 0, per_cu = 0;
        hipGetDevice(&dev); hipDeviceGetAttribute(&cus, hipDeviceAttributeMultiprocessorCount, dev);
        if (hipFuncSetAttribute((const void*)fwd_kernel, hipFuncAttributeMaxDynamicSharedMemorySize, LDS_BYTES) != hipSuccess) { fprintf(stderr, "kernel_launch: hipFuncSetAttribute failed\n"); grid = -1; return; }
        if (hipOccupancyMaxActiveBlocksPerMultiprocessor(&per_cu, (const void*)fwd_kernel, NWAVES * 64, LDS_BYTES) != hipSuccess || per_cu < 1) { fprintf(stderr, "kernel_launch: occupancy query says %d\n", per_cu); grid = -1; return; }
        grid = cus;
    }
    if (grid < 0) return;
    Args a{};
    for (int i = 0; i < 22; ++i) a.in[i] = (const float*)d_in[i];
    a.out = (float*)d_out; a.ws = (unsigned char*)d_ws; a.ph_lo = 0; a.ph_hi = N_PHASES;
    void* kargs[] = {&a};
    hipError_t e = hipLaunchCooperativeKernel((const void*)fwd_kernel, dim3(grid), dim3(NWAVES * 64), kargs, LDS_BYTES, stream);
    if (e != hipSuccess) fprintf(stderr, "cooperative launch failed: %s (grid %d)\n", hipGetErrorString(e), grid);
}
```

```cpp
#include <hip/hip_runtime.h>
#include <cstdio>
#include <cstdint>

namespace pg8 {
#define PG8_LAS __attribute__((address_space(3)))
typedef unsigned short bf16_t;
typedef short bf16x8 __attribute__((ext_vector_type(8)));
typedef float f32x4 __attribute__((ext_vector_type(4)));
typedef unsigned u32x4 __attribute__((ext_vector_type(4)));
constexpr int BM = 256, BK = 64, HALF = 128, HTB = HALF * BK * 2  , STAGE_BYTES = 8 * HTB, NXCD = 8, WGM = 8;

__host__ __device__ __forceinline__ int lds_byte(int r, int c) { const int st = (r >> 4) * 2 + (c >> 5), rr = r & 15, cc = c & 31, ob = rr * 64 + cc * 2; return st * 1024 + (ob ^ (((ob >> 9) & 1) << 5)); }
__host__ __device__ __forceinline__ void stage_rc(int b, int& R, int& C) { const int st = b / 1024, sb = b % 1024, swz = sb ^ (((sb >> 9) & 1) << 5); R = (st >> 1) * 16 + swz / 64; C = (st & 1) * 32 + (swz % 64) / 2; }
__host__ __device__ __forceinline__ int perm32(int rho) { const int n = rho >> 4, i = rho & 15; return 8 * (i >> 2) + 4 * n + (i & 3); }

struct Unit { int pm, pn; };
struct Gemm { const bf16_t* A; const bf16_t* Bt; int M, N, K; };

struct StaticOrder {
    int nM, nN, nwg, G, c;
    __host__ __device__ void init(int M, int N, int G_, int c_) { nM = M / BM; nN = N / BM; nwg = nM * nN; G = G_; c = c_; }
    __host__ __device__ bool next(int i, Unit& u) const {
        const long L = (long)i * G + c; if (L >= nwg) return false;
        int wgid = (int)L; { const int q = nwg / NXCD, r = nwg % NXCD, xcd = wgid % NXCD, off = wgid / NXCD; wgid = (xcd < r ? xcd * (q + 1) : r * (q + 1) + (xcd - r) * q) + off; }
        const int nig = WGM * nN, gid = wgid / nig, fm = gid * WGM, gsz = (nM - fm) < WGM ? (nM - fm) : WGM;
        u.pm = fm + ((wgid % nig) % gsz); u.pn = (wgid % nig) / gsz; return true;
    }
    __device__ __forceinline__ void a_ready(const Unit&) const {}
    __device__ __forceinline__ void done(const Unit&) const {}
};

__device__ __forceinline__ unsigned cvt_pk_bf16(float lo, float hi) { unsigned r; asm volatile("v_cvt_pk_bf16_f32 %0, %1, %2" : "=v"(r) : "v"(lo), "v"(hi)); return r; }

struct EpiBf16 {
    static constexpr bool PERM = true, AFTER_DRAIN = false;
    bf16_t* O; int ldc;
    __device__ __forceinline__ void operator()(const f32x4 (&acc)[2][2][4][2], const Unit& u, int wr, int wc, int fr, int fq) const {
        const int row0 = u.pm * BM + wr * 64 + fr; const int col0 = u.pn * BM + wc * 32 + 8 * fq;
#pragma unroll
        for (int ai = 0; ai < 2; ++ai)
#pragma unroll
            for (int m = 0; m < 4; ++m) { bf16_t* rowp = O + (size_t)(row0 + ai * HALF + m * 16) * ldc + col0;
#pragma unroll
                for (int bj = 0; bj < 2; ++bj) { const f32x4 v0 = acc[ai][bj][m][0], v1 = acc[ai][bj][m][1];
                    u32x4 w; w.x = cvt_pk_bf16(v0[0], v0[1]); w.y = cvt_pk_bf16(v0[2], v0[3]); w.z = cvt_pk_bf16(v1[0], v1[1]); w.w = cvt_pk_bf16(v1[2], v1[3]);
                    *(u32x4*)(rowp + bj * HALF) = w; } }
    }
};
__device__ __forceinline__ float silu_f(float x) { return x * __builtin_amdgcn_rcpf(1.0f + __expf(-x)); }
struct EpiSwiglu {
    static constexpr bool PERM = true, AFTER_DRAIN = false;
    bf16_t* O; int ldc;
    __device__ __forceinline__ void operator()(const f32x4 (&acc)[2][2][4][2], const Unit& u, int wr, int wc, int fr, int fq) const {
        const int row0 = u.pm * BM + wr * 64 + fr; const int col0 = u.pn * HALF + wc * 32 + 8 * fq;
#pragma unroll
        for (int ai = 0; ai < 2; ++ai)
#pragma unroll
            for (int m = 0; m < 4; ++m) { bf16_t* rowp = O + (size_t)(row0 + ai * HALF + m * 16) * ldc + col0;
                const f32x4 g0 = acc[ai][0][m][0], g1 = acc[ai][0][m][1], u0 = acc[ai][1][m][0], u1 = acc[ai][1][m][1];
                float a[8];
#pragma unroll
                for (int j = 0; j < 4; ++j) { a[j] = silu_f(g0[j]) * u0[j]; a[4 + j] = silu_f(g1[j]) * u1[j]; }
                u32x4 w; w.x = cvt_pk_bf16(a[0], a[1]); w.y = cvt_pk_bf16(a[2], a[3]); w.z = cvt_pk_bf16(a[4], a[5]); w.w = cvt_pk_bf16(a[6], a[7]);
                *(u32x4*)rowp = w; }
    }
};
struct EpiResid {
    static constexpr bool PERM = false, AFTER_DRAIN = false;
    const float* base; float* out; const float* gate; float coef;
    __device__ __forceinline__ void operator()(const f32x4 (&acc)[2][2][4][2], const Unit& u, int wr, int wc, int fr, int fq) const {
        const int row0 = u.pm * BM + wr * 64 + fr; const int col0 = u.pn * BM + wc * 32 + 4 * fq;
        const float* grow = gate + (size_t)(u.pm >> 3) * 9216 + col0;
#pragma unroll
        for (int bj = 0; bj < 2; ++bj)
#pragma unroll
            for (int n = 0; n < 2; ++n) { const f32x4 gv = *(const f32x4*)(grow + bj * HALF + n * 16) * coef;
#pragma unroll
                for (int ai = 0; ai < 2; ++ai)
#pragma unroll
                    for (int m = 0; m < 4; ++m) { const size_t off = (size_t)(row0 + ai * HALF + m * 16) * 1024 + col0 + bj * HALF + n * 16;
                        const f32x4 bs = *(const f32x4*)(base + off); *(f32x4*)(out + off) = bs + gv * acc[ai][bj][m][n]; } }
    }
};
struct EpiQRope {
    static constexpr bool PERM = true, AFTER_DRAIN = false;
    bf16_t* O; int ldc; const float* cs; float qscale;
    __device__ __forceinline__ void operator()(const f32x4 (&acc)[2][2][4][2], const Unit& u, int wr, int wc, int fr, int fq) const {
        const int row0 = u.pm * BM + wr * 64 + fr;
#pragma unroll
        for (int bj = 0; bj < 2; ++bj) { const int col0 = u.pn * BM + bj * HALF + wc * 32 + 8 * fq; const int off = col0 % 192; const bool rope = off >= 128; const int g = rope ? ((off - 128) >> 3) : 0;
#pragma unroll
            for (int ai = 0; ai < 2; ++ai)
#pragma unroll
                for (int m = 0; m < 4; ++m) { const int row = row0 + ai * HALF + m * 16; f32x4 v0 = acc[ai][bj][m][0], v1 = acc[ai][bj][m][1];
                    const float* c = cs + ((size_t)(row & 2047) * 32 + 4 * g) * 2; f32x4 c01 = *(const f32x4*)c, c23 = *(const f32x4*)(c + 4);
                    if (!rope) { c01 = (f32x4){1.f, 0.f, 1.f, 0.f}; c23 = c01; }
                    const float co[4] = {c01[0], c01[2], c23[0], c23[2]}, si[4] = {c01[1], c01[3], c23[1], c23[3]};
#pragma unroll
                    for (int j = 0; j < 4; ++j) { const float x1 = v0[j], x2 = v1[j]; v0[j] = (x1 * co[j] - x2 * si[j]) * qscale; v1[j] = (x2 * co[j] + x1 * si[j]) * qscale; }
                    u32x4 w; w.x = cvt_pk_bf16(v0[0], v0[1]); w.y = cvt_pk_bf16(v0[2], v0[3]); w.z = cvt_pk_bf16(v1[0], v1[1]); w.w = cvt_pk_bf16(v1[2], v1[3]);
                    *(u32x4*)(O + (size_t)row * ldc + col0) = w;
                    asm volatile("" ::: "memory"); } }
    }
};

template <class Epi, class Sched, bool ALIGN_EPI = false, bool SP2 = false>
__device__ __forceinline__ void gemm_phase(PG8_LAS unsigned char* lds, const Gemm g, const Sched& S, const Epi& E) {
    const int tid = threadIdx.x, wid = __builtin_amdgcn_readfirstlane(tid >> 6), lane = tid & 63, wr = wid >> 2, wc = wid & 3, fr = lane & 15, fq = lane >> 4;
    int Kop = g.K; asm volatile("" : "+s"(Kop));
    const int K = Kop, nt = K / BK;
    unsigned voffA[2], voffB[2];
#pragma unroll
    for (int i = 0; i < 2; ++i) { int R, C; stage_rc(tid * 16 + i * 8192, R, C); const int Rb = Epi::PERM ? ((R & ~31) + perm32(R & 31)) : R;
        voffA[i] = (unsigned)(R * K + C) * 2u; voffB[i] = (unsigned)(Rb * K + C) * 2u; }
    const size_t kstep = (size_t)(BK * 2);
    const size_t hstep = (size_t)HALF * K * 2;
    const size_t tstep = 2 * hstep;
    const unsigned ldsw = (unsigned)wid * 1024u;
    const int aoff = lds_byte(wr * 64 + fr, fq * 8), boff = lds_byte(wc * 32 + fr, fq * 8);
#define PG8_SA(b, h) (((b) * 2 + (h)) * HTB)
#define PG8_SB(b, h) ((4 + (b) * 2 + (h)) * HTB)
#define PG8_STAGE(bufoff, gbase, voff) do { _Pragma("unroll") for (int _i = 0; _i < 2; ++_i) \
        __builtin_amdgcn_global_load_lds((const unsigned*)((const char*)(gbase) + (voff)[_i]), (PG8_LAS unsigned*)(lds + (bufoff) + ldsw + _i * 8192), 16, 0, 0); } while (0)
#define PG8_LDA(dst, b, h) do { _Pragma("unroll") for (int m = 0; m < 4; ++m) _Pragma("unroll") for (int k = 0; k < 2; ++k) dst[m][k] = *(const PG8_LAS bf16x8*)(lds + PG8_SA(b, h) + aoff + m * 2048 + k * 1024); } while (0)
#define PG8_LDB(dst, b, h) do { _Pragma("unroll") for (int n = 0; n < 2; ++n) _Pragma("unroll") for (int k = 0; k < 2; ++k) dst[n][k] = *(const PG8_LAS bf16x8*)(lds + PG8_SB(b, h) + boff + n * 2048 + k * 1024); } while (0)
#define PG8_MMA(ai, bj, At, Bt) do { __builtin_amdgcn_s_setprio(1); _Pragma("unroll") for (int m = 0; m < 4; ++m) _Pragma("unroll") for (int n = 0; n < 2; ++n) _Pragma("unroll") for (int k = 0; k < 2; ++k) \
        acc[ai][bj][m][n] = __builtin_amdgcn_mfma_f32_16x16x32_bf16(Bt[n][k], At[m][k], acc[ai][bj][m][n], 0, 0, 0); __builtin_amdgcn_s_setprio(0); } while (0)
#define PG8_WAIT_V(n) asm volatile("s_waitcnt vmcnt(" #n ")" ::: "memory")
#define PG8_WAIT_L(n) asm volatile("s_waitcnt lgkmcnt(" #n ")" ::: "memory")
#define PG8_BAR __builtin_amdgcn_s_barrier()
#define PG8_SCHED __builtin_amdgcn_sched_barrier(0)
    Unit cur, nxt; int ui = 0;
    if (!S.next(0, cur)) return;
    f32x4 acc[2][2][4][2];
#pragma unroll
    for (int a = 0; a < 2; ++a)
#pragma unroll
        for (int b = 0; b < 2; ++b)
#pragma unroll
            for (int m = 0; m < 4; ++m)
#pragma unroll
                for (int n = 0; n < 2; ++n) acc[a][b][m][n] = (f32x4){0.f, 0.f, 0.f, 0.f};
    bf16x8 At[4][2], B0[2][2], B1[2][2];
    const char* cA = (const char*)g.A + (size_t)cur.pm * tstep; const char* cB = (const char*)g.Bt + (size_t)cur.pn * tstep;
    S.a_ready(cur);
    if constexpr (SP2) {
        PG8_STAGE(PG8_SB(0, 0), cB, voffB); PG8_STAGE(PG8_SB(0, 1), cB + hstep, voffB); PG8_STAGE(PG8_SA(0, 0), cA, voffA); PG8_STAGE(PG8_SA(0, 1), cA + hstep, voffA);
        if (wr == 1) PG8_BAR;
        PG8_WAIT_V(2); PG8_BAR;
        PG8_STAGE(PG8_SB(1, 0), cB + kstep, voffB); PG8_STAGE(PG8_SA(1, 0), cA + kstep, voffA); PG8_STAGE(PG8_SB(1, 1), cB + hstep + kstep, voffB);
        PG8_WAIT_V(6); PG8_BAR;
    } else {
        PG8_STAGE(PG8_SB(0, 0), cB, voffB); PG8_STAGE(PG8_SA(0, 0), cA, voffA); PG8_STAGE(PG8_SB(0, 1), cB + hstep, voffB); PG8_STAGE(PG8_SA(0, 1), cA + hstep, voffA);
        if (wr == 1) PG8_BAR;
        PG8_WAIT_V(4); PG8_BAR;
        PG8_STAGE(PG8_SB(1, 0), cB + kstep, voffB); PG8_STAGE(PG8_SA(1, 0), cA + kstep, voffA); PG8_STAGE(PG8_SB(1, 1), cB + hstep + kstep, voffB);
        PG8_WAIT_V(6); PG8_BAR;
    }
    for (;;) {
        const bool has_next = S.next(ui + 1, nxt);
        const char* nA = has_next ? (const char*)g.A + (size_t)nxt.pm * tstep : cA; const char* nB = has_next ? (const char*)g.Bt + (size_t)nxt.pn * tstep : cB;
        for (int t = 0; t < nt; t += 2) {
            const bool last = (t == nt - 2);
            const char* a1 = cA + (size_t)(t + 1) * kstep;
            const char* a2 = last ? nA : cA + (size_t)(t + 2) * kstep; const char* b2 = last ? nB : cB + (size_t)(t + 2) * kstep;
            const char* a3 = a2 + kstep; const char* b3 = b2 + kstep;
            if (last && has_next) S.a_ready(nxt);
            if constexpr (SP2) {
            PG8_LDB(B0, 0, 0); PG8_LDB(B1, 0, 1); PG8_SCHED; PG8_LDA(At, 0, 0); PG8_STAGE(PG8_SA(1, 1), a1 + hstep, voffA);
            PG8_WAIT_V(8); PG8_WAIT_L(0); PG8_BAR; PG8_MMA(0, 0, At, B0); PG8_MMA(0, 1, At, B1); PG8_BAR; PG8_SCHED;
            PG8_LDA(At, 0, 1); PG8_STAGE(PG8_SB(0, 0), b2, voffB); PG8_STAGE(PG8_SB(0, 1), b2 + hstep, voffB); PG8_STAGE(PG8_SA(0, 0), a2, voffA);
            PG8_WAIT_V(8); PG8_WAIT_L(0); PG8_BAR; PG8_MMA(1, 0, At, B0); PG8_MMA(1, 1, At, B1); PG8_BAR; PG8_SCHED;
            PG8_LDB(B0, 1, 0); PG8_LDB(B1, 1, 1); PG8_SCHED; PG8_LDA(At, 1, 0); PG8_STAGE(PG8_SA(0, 1), a2 + hstep, voffA);
            PG8_WAIT_V(8); PG8_WAIT_L(0); PG8_BAR; PG8_MMA(0, 0, At, B0); PG8_MMA(0, 1, At, B1); PG8_BAR; PG8_SCHED;
            PG8_LDA(At, 1, 1); PG8_STAGE(PG8_SB(1, 0), b3, voffB); PG8_STAGE(PG8_SB(1, 1), b3 + hstep, voffB); PG8_STAGE(PG8_SA(1, 0), a3, voffA);
            PG8_WAIT_V(8); PG8_WAIT_L(0); PG8_BAR; PG8_MMA(1, 0, At, B0); PG8_MMA(1, 1, At, B1); PG8_BAR; PG8_SCHED;
            } else {
            PG8_LDB(B0, 0, 0); PG8_SCHED; PG8_LDA(At, 0, 0); PG8_STAGE(PG8_SA(1, 1), a1 + hstep, voffA);
            PG8_WAIT_L(8); PG8_BAR; PG8_WAIT_L(0); PG8_MMA(0, 0, At, B0); PG8_BAR; PG8_SCHED;
            PG8_LDB(B1, 0, 1); PG8_STAGE(PG8_SB(0, 0), b2, voffB);
            PG8_BAR; PG8_WAIT_L(0); PG8_MMA(0, 1, At, B1); PG8_BAR;
            PG8_LDA(At, 0, 1); PG8_STAGE(PG8_SA(0, 0), a2, voffA);
            PG8_BAR; PG8_WAIT_L(0); PG8_MMA(1, 0, At, B0); PG8_BAR; PG8_SCHED;
            PG8_STAGE(PG8_SB(0, 1), b2 + hstep, voffB);
            PG8_WAIT_V(6); PG8_BAR; PG8_MMA(1, 1, At, B1); PG8_BAR;
            PG8_LDB(B0, 1, 0); PG8_SCHED; PG8_LDA(At, 1, 0); PG8_STAGE(PG8_SA(0, 1), a2 + hstep, voffA);
            PG8_WAIT_L(8); PG8_BAR; PG8_WAIT_L(0); PG8_MMA(0, 0, At, B0); PG8_BAR; PG8_SCHED;
            PG8_LDB(B1, 1, 1); PG8_STAGE(PG8_SB(1, 0), b3, voffB);
            PG8_BAR; PG8_WAIT_L(0); PG8_MMA(0, 1, At, B1); PG8_BAR;
            PG8_LDA(At, 1, 1); PG8_STAGE(PG8_SA(1, 0), a3, voffA);
            PG8_BAR; PG8_WAIT_L(0); PG8_MMA(1, 0, At, B0); PG8_BAR; PG8_SCHED;
            PG8_STAGE(PG8_SB(1, 1), b3 + hstep, voffB);
            PG8_WAIT_V(6); PG8_BAR; PG8_MMA(1, 1, At, B1); PG8_BAR;
            }
        }
        if constexpr (ALIGN_EPI) { if (wr == 0) PG8_BAR; }
        E(acc, cur, wr, wc, fr, fq); S.done(cur);
        if (!has_next) break;
#pragma unroll
        for (int a = 0; a < 2; ++a)
#pragma unroll
            for (int b = 0; b < 2; ++b)
#pragma unroll
                for (int m = 0; m < 4; ++m)
#pragma unroll
                    for (int n = 0; n < 2; ++n) acc[a][b][m][n] = (f32x4){0.f, 0.f, 0.f, 0.f};
        cur = nxt; cA = nA; cB = nB; ++ui;
        if constexpr (ALIGN_EPI) { if (wr == 1) PG8_BAR; }
    }
    PG8_WAIT_V(0);
    if constexpr (!ALIGN_EPI) { if (wr == 0) PG8_BAR; }
    PG8_BAR;
#undef PG8_SA
#undef PG8_SB
#undef PG8_STAGE
#undef PG8_LDA
#undef PG8_LDB
#undef PG8_MMA
#undef PG8_WAIT_V
#undef PG8_WAIT_L
#undef PG8_BAR
#undef PG8_SCHED
}
}

namespace att {
#define ATT_LAS __attribute__((address_space(3)))
typedef unsigned short bf16_t;
typedef short bf16x8 __attribute__((ext_vector_type(8)));
typedef short s16x4 __attribute__((ext_vector_type(4)));
typedef float f32x16 __attribute__((ext_vector_type(16)));
typedef unsigned u32x4 __attribute__((ext_vector_type(4)));
#define ATT_SBAR() __builtin_amdgcn_sched_barrier(0)
__device__ __forceinline__ int crow(int r, int hi) { return (r & 3) + 8 * (r >> 2) + 4 * hi; }
__device__ __forceinline__ unsigned cvtpk(float lo, float hi) { unsigned r; asm volatile("v_cvt_pk_bf16_f32 %0, %1, %2" : "=v"(r) : "v"(lo), "v"(hi)); return r; }
template <int D> __device__ __forceinline__ int kswz(int row, int chunk) { return row * (D * 2) + ((chunk * 16) ^ ((row & 7) << 4)); }
template <int NCB> __device__ __forceinline__ int v_st(int k, int c) { const int kk = (k & ~0xC) | ((k & 4) << 1) | ((k & 8) >> 1); return ((kk >> 3) * NCB + (c >> 5)) * 512 + ((kk & 7) * 32 + (c & 31)) * 2; }
__device__ __forceinline__ int v_rd_base(int lane) { return ((lane & 3) << 3) | (((lane >> 2) & 3) << 6) | (((lane >> 4) & 1) << 5) | (((lane >> 5) & 1) << 8); }

template <int DN, int DR, int DV, bool SWA>
struct Body {
    static constexpr int KN_B = 64 * DN * 2, KR_B = 64 * DR * 2, V_B = 64 * DV * 2, K_B = KN_B + KR_B, BUF_B = K_B + V_B;
    static constexpr int NCB = DV / 32, GS = NCB * 512;
    static constexpr int NQ = (DN + DR) / 16;
    static constexpr int NCH_KN = 64 * DN / 8 / 512, NCH_KR = (DR > 0) ? 1 : 0, NCH_V = 64 * DV / 8 / 512;
    static constexpr int OFF_SCR = 2 * BUF_B, OFF_BIAS = OFF_SCR + 8 * 256, LDS_TOTAL = OFF_BIAS + 384 * 4;
    static_assert(DR == 0 || DR == 64, "rope dims");

    struct Stage { bf16x8 kn[NCH_KN]; bf16x8 kr[NCH_KR ? NCH_KR : 1]; bf16x8 v[NCH_V]; };

    __device__ static __forceinline__ void stage_load(Stage& S, const bf16_t* KN, int knp, const bf16_t* KR, int krp, const bf16_t* V, int vp, int kb, int tid) {
#pragma unroll
        for (int i = 0; i < NCH_KN; ++i) { const int ci = tid + 512 * i, row = ci / (DN / 8), ch = ci % (DN / 8); S.kn[i] = *(const bf16x8*)(KN + (size_t)(kb + row) * knp + ch * 8); }
        if constexpr (DR > 0) { const int row = tid >> 3, ch = tid & 7; S.kr[0] = *(const bf16x8*)(KR + (size_t)(kb + row) * krp + ch * 8); }
#pragma unroll
        for (int i = 0; i < NCH_V; ++i) { const int ci = tid + 512 * i, row = ci / (DV / 8), ch = ci % (DV / 8); S.v[i] = *(const bf16x8*)(V + (size_t)(kb + row) * vp + ch * 8); }
    }
    __device__ static __forceinline__ void stage_write(const Stage& S, ATT_LAS char* lds, int cur, int tid) {
        ATT_LAS char* kbuf = lds + 2 * V_B + cur * K_B; ATT_LAS char* vbuf = lds + cur * V_B;
#pragma unroll
        for (int i = 0; i < NCH_KN; ++i) { const int ci = tid + 512 * i, row = ci / (DN / 8), ch = ci % (DN / 8); *(ATT_LAS bf16x8*)(kbuf + kswz<DN>(row, ch)) = S.kn[i]; }
        if constexpr (DR > 0) { const int row = tid >> 3, ch = tid & 7; *(ATT_LAS bf16x8*)(kbuf + KN_B + kswz<64>(row, ch)) = S.kr[0]; }
#pragma unroll
        for (int i = 0; i < NCH_V; ++i) { const int ci = tid + 512 * i, row = ci / (DV / 8), ch = ci % (DV / 8); *(ATT_LAS bf16x8*)(vbuf + v_st<NCB>(row, ch * 8)) = S.v[i]; }
    }
    template <int D> __device__ static __forceinline__ void qk_acc(f32x16& p0, f32x16& p1, const ATT_LAS char* Kt, int r32, int hi, const bf16x8* qr) {
        const ATT_LAS char* kb[4];
#pragma unroll
        for (int dd = 0; dd < 4; ++dd) kb[dd] = Kt + kswz<D>(r32, 2 * dd + hi);
#pragma unroll
        for (int d0 = 0; d0 < D / 16; ++d0) { const ATT_LAS char* a = kb[d0 & 3] + (d0 >> 2) * 128;
            const bf16x8 b0 = *(const ATT_LAS bf16x8*)a; const bf16x8 b1 = *(const ATT_LAS bf16x8*)(a + 32 * D * 2);
            p0 = __builtin_amdgcn_mfma_f32_32x32x16_bf16(b0, qr[d0], p0, 0, 0, 0);
            p1 = __builtin_amdgcn_mfma_f32_32x32x16_bf16(b1, qr[d0], p1, 0, 0, 0); }
    }
    template <int VOFF> __device__ static __forceinline__ void pv_tile(f32x16* o, int vaddr, bf16x8 pa0, bf16x8 pa1, bf16x8 pa2, bf16x8 pa3) {
#define ATT_TRRD(dst, off) asm volatile("ds_read_b64_tr_b16 %0, %1 offset:%2" : "=&v"(dst) : "v"(vaddr), "i"(off) : "memory")
#pragma unroll
        for (int d0 = 0; d0 < NCB; ++d0) { s16x4 l0, l1, l2, l3, h0, h1, h2, h3; const int b_ = VOFF + d0 * 512;
            ATT_TRRD(l0, b_); ATT_TRRD(h0, b_ + GS); ATT_TRRD(l1, b_ + 2 * GS); ATT_TRRD(h1, b_ + 3 * GS); ATT_TRRD(l2, b_ + 4 * GS); ATT_TRRD(h2, b_ + 5 * GS); ATT_TRRD(l3, b_ + 6 * GS); ATT_TRRD(h3, b_ + 7 * GS);
            asm volatile("s_waitcnt lgkmcnt(0)" ::: "memory"); ATT_SBAR();
            o[d0] = __builtin_amdgcn_mfma_f32_32x32x16_bf16(pa0, (bf16x8){l0[0], l0[1], l0[2], l0[3], h0[0], h0[1], h0[2], h0[3]}, o[d0], 0, 0, 0);
            o[d0] = __builtin_amdgcn_mfma_f32_32x32x16_bf16(pa1, (bf16x8){l1[0], l1[1], l1[2], l1[3], h1[0], h1[1], h1[2], h1[3]}, o[d0], 0, 0, 0);
            o[d0] = __builtin_amdgcn_mfma_f32_32x32x16_bf16(pa2, (bf16x8){l2[0], l2[1], l2[2], l2[3], h2[0], h2[1], h2[2], h2[3]}, o[d0], 0, 0, 0);
            o[d0] = __builtin_amdgcn_mfma_f32_32x32x16_bf16(pa3, (bf16x8){l3[0], l3[1], l3[2], l3[3], h3[0], h3[1], h3[2], h3[3]}, o[d0], 0, 0, 0); }
#undef ATT_TRRD
    }

    struct State { bf16x8 qr[NQ]; f32x16 o[NCB]; float m, l; };

    template <int CUR> __device__ static __forceinline__ void tile(State& st, ATT_LAS char* lds, int ldsaddr, int r32, int hi, int wid, int dq, unsigned W, bool needmask, float scl) {
        const ATT_LAS char* buf = lds + 2 * V_B + CUR * K_B;
        f32x16 p0 = {}, p1 = {};
        qk_acc<DN>(p0, p1, buf, r32, hi, st.qr);
        if constexpr (DR > 0) qk_acc<DR>(p0, p1, buf + KN_B, r32, hi, st.qr + DN / 16);
        if constexpr (SWA) {
            const ATT_LAS float* tl = (const ATT_LAS float*)(lds + OFF_BIAS) + (256 - dq);
#pragma unroll
            for (int r = 0; r < 16; ++r) { const int c = (r & 3) + 8 * (r >> 2); p0[r] = fmaf(p0[r], scl, tl[c]); p1[r] = fmaf(p1[r], scl, tl[c + 32]); }
        }
        if (needmask) { const float NEG = -__builtin_inff();
#pragma unroll
            for (int r = 0; r < 16; ++r) { const int c = (r & 3) + 8 * (r >> 2);
                if ((unsigned)(dq - c) >= W) p0[r] = NEG;
                if ((unsigned)(dq - c - 32) >= W) p1[r] = NEG; } }
        float pmax = p0[0];
#pragma unroll
        for (int r = 1; r < 16; ++r) pmax = fmaxf(pmax, p0[r]);
#pragma unroll
        for (int r = 0; r < 16; ++r) pmax = fmaxf(pmax, p1[r]);
        { auto rr = __builtin_amdgcn_permlane32_swap(__float_as_uint(pmax), __float_as_uint(pmax), false, false); pmax = fmaxf(__uint_as_float(rr[0]), __uint_as_float(rr[1])); }
        const float mn = fmaxf(st.m, pmax); const float alpha = __builtin_amdgcn_exp2f(st.m - mn); st.m = mn;
        float ps = 0.f;
#pragma unroll
        for (int r = 0; r < 16; ++r) { p0[r] = __builtin_amdgcn_exp2f(p0[r] - mn); p1[r] = __builtin_amdgcn_exp2f(p1[r] - mn); ps += p0[r] + p1[r]; }
        { auto rr = __builtin_amdgcn_permlane32_swap(__float_as_uint(ps), __float_as_uint(ps), false, false); ps = __uint_as_float(rr[0]) + __uint_as_float(rr[1]); }
        st.l = st.l * alpha + ps;
        bf16x8 pa0, pa1, pa2, pa3;
#define ATT_PK4(P, B_, OUT) do { unsigned a0 = cvtpk(P[B_ + 0], P[B_ + 1]), a1 = cvtpk(P[B_ + 2], P[B_ + 3]); unsigned b0 = cvtpk(P[B_ + 4], P[B_ + 5]), b1 = cvtpk(P[B_ + 6], P[B_ + 7]); \
        auto r0 = __builtin_amdgcn_permlane32_swap(a0, b0, false, false); auto r1 = __builtin_amdgcn_permlane32_swap(a1, b1, false, false); \
        u32x4 w = {r0[0], r1[0], r0[1], r1[1]}; OUT = *reinterpret_cast<bf16x8*>(&w); } while (0)
        ATT_PK4(p0, 0, pa0); ATT_PK4(p0, 8, pa1); ATT_PK4(p1, 0, pa2); ATT_PK4(p1, 8, pa3);
#undef ATT_PK4
        if (__any(alpha < 1.f)) { ATT_LAS float* al = (ATT_LAS float*)(lds + OFF_SCR) + wid * 64;
            if (hi == 0) al[r32] = alpha;
            asm volatile("s_waitcnt lgkmcnt(0)" ::: "memory");
#pragma unroll
            for (int r = 0; r < 16; ++r) { const float a = al[crow(r, hi)];
#pragma unroll
                for (int d0 = 0; d0 < NCB; ++d0) st.o[d0][r] *= a; }
            asm volatile("s_waitcnt lgkmcnt(0)" ::: "memory"); }
        ATT_SBAR();
        pv_tile<CUR * V_B>(st.o, ldsaddr, pa0, pa1, pa2, pa3);
    }

    __device__ static __forceinline__ void unit(ATT_LAS char* lds, const bf16_t* Qrow, int qpitch, const bf16_t* KN, int knp, const bf16_t* KR, int krp, const bf16_t* V, int vp,
                                                bf16_t* Orow, int opitch, int r0, int kb0, int NT, unsigned W, float scl, float sinkl2) {
        const int tid = threadIdx.x, lane = tid & 63, r32 = lane & 31, hi = lane >> 5; const int wid = __builtin_amdgcn_readfirstlane(tid >> 6);
        const int ldsaddr = (int)(unsigned)(uintptr_t)lds + v_rd_base(lane);
        State st;
#pragma unroll
        for (int d0 = 0; d0 < NQ; ++d0) st.qr[d0] = *(const bf16x8*)(Qrow + (size_t)r32 * qpitch + d0 * 16 + hi * 8);
#pragma unroll
        for (int d0 = 0; d0 < NCB; ++d0) st.o[d0] = f32x16{};
        st.m = -1e30f; st.l = 0.f;
        Stage sg;
        stage_load(sg, KN, knp, KR, krp, V, vp, kb0, tid);
        stage_write(sg, lds, 0, tid);
        __syncthreads();
        const int rowpos = r0 + r32;
#define ATT_STEP(CUR, t) do { const int kb_ = kb0 + 64 * (t); const bool more_ = (t) + 1 < NT; \
        if (more_) stage_load(sg, KN, knp, KR, krp, V, vp, kb_ + 64, tid); \
        const bool act_ = (kb_ <= r0 + 31) && ((long)kb_ + 63 >= (long)r0 - (long)(W - 1u)); \
        if (act_) { const bool nm_ = SWA || (kb_ + 63 > r0); tile<CUR>(st, lds, ldsaddr, r32, hi, wid, rowpos - kb_ - 4 * hi, W, nm_, scl); } \
        if (more_) stage_write(sg, lds, (CUR) ^ 1, tid); \
        __syncthreads(); } while (0)
        int t = 0;
        for (; t + 1 < NT; t += 2) { ATT_STEP(0, t); ATT_STEP(1, t + 1); }
        if (t < NT) { ATT_STEP(0, t); }
#undef ATT_STEP
        if constexpr (SWA) st.l += __builtin_amdgcn_exp2f(sinkl2 - st.m);
        ATT_LAS float* li = (ATT_LAS float*)(lds + OFF_SCR) + wid * 64 + 32;
        if (hi == 0) li[r32] = st.l;
        asm volatile("s_waitcnt lgkmcnt(0)" ::: "memory");
        float rli[16];
#pragma unroll
        for (int r = 0; r < 16; ++r) rli[r] = __builtin_amdgcn_rcpf(li[crow(r, hi)]);
#pragma unroll
        for (int r = 0; r < 16; ++r) { const int orow = crow(r, hi);
#pragma unroll
            for (int d0 = 0; d0 < NCB; ++d0) { const float v = st.o[d0][r] * rli[r]; const float vn = __shfl_xor(v, 1);
                if ((r32 & 1) == 0) *(unsigned*)(Orow + (size_t)orow * opitch + d0 * 32 + r32) = cvtpk(v, vn); } }
        __syncthreads();
    }
};
}

constexpr int D_MODEL = 1024, BATCH = 8, SEQ = 2048, M = BATCH * SEQ, D_FF = 2816, N_MOD = 9;
constexpr int D_IN = 1216, D_IN_PAD = 1280;
constexpr float EPS = 1e-6f;
constexpr float L2E = 1.4426950408889634f;
constexpr int NWAVES = 8;

constexpr size_t MiB = 1u << 20;
constexpr size_t WS_CTL = 0;
constexpr size_t WS_MOD = 1 * MiB;
constexpr size_t WS_ROPE = 2 * MiB;
constexpr size_t WS_W1GU = 4 * MiB;
constexpr size_t WS_W1D = 15 * MiB;
constexpr size_t WS_W2GU = 21 * MiB;
constexpr size_t WS_W2D = 32 * MiB;
constexpr size_t WS_WIN = 38 * MiB;
constexpr size_t WS_WO = 41 * MiB;
constexpr size_t WS_WUQ = 43 * MiB;
constexpr size_t WS_WUKV = 44 * MiB;
constexpr size_t WS_H = 46 * MiB;
constexpr size_t WS_ACT = 78 * MiB;
constexpr size_t WS_PROJ = 78 * MiB;
constexpr size_t WS_Q = 118 * MiB;
constexpr size_t WS_KV = 142 * MiB;
constexpr size_t WS_MIX = 174 * MiB;
constexpr size_t WS_QN = 206 * MiB;
constexpr size_t WS_KVN = 214 * MiB;
constexpr size_t WS_KR = 218 * MiB;
constexpr size_t WS_END = 220 * MiB;

constexpr int LDS_BYTES = 147456;

typedef unsigned short bf16;
typedef float f32x4 __attribute__((ext_vector_type(4)));
typedef unsigned v4u __attribute__((ext_vector_type(4)));
typedef short bf16x8 __attribute__((ext_vector_type(8)));
#define LAS __attribute__((address_space(3)))

__device__ __forceinline__ unsigned f2bf(float f) { unsigned u = __builtin_bit_cast(unsigned, f); return (u + 0x7fffu + ((u >> 16) & 1u)) >> 16; }
__device__ __forceinline__ unsigned pk2(float lo, float hi) { return f2bf(lo) | (f2bf(hi) << 16); }
__device__ __forceinline__ float bf2f(unsigned short h) { return __builtin_bit_cast(float, (unsigned)h << 16); }
__device__ __forceinline__ float wave_sum(float v) {
#pragma unroll
    for (int o = 1; o < 64; o <<= 1) v += __shfl_xor(v, o);
    return v;
}

typedef __attribute__((address_space(1))) unsigned gu32;
#define RLX_AGENT __ATOMIC_RELAXED, __HIP_MEMORY_SCOPE_AGENT
#define XB_TMO      128
#define XB_XCNT(j)  (256  + 64 * (j))
#define XB_XSUB(j)  (1280 + 64 * (j))
#define XB_XGEN(j)  (2304 + 64 * (j))
#define XB_TOP      3328
#define XB_TOPGEN   3392
#define XCD_BAR_WORDS 3456
#define XB_SPIN_CAP (1u << 18)

__device__ __forceinline__ unsigned xb_ld(unsigned* p)              { return __hip_atomic_load(p, __ATOMIC_RELAXED, __HIP_MEMORY_SCOPE_AGENT); }
__device__ __forceinline__ unsigned xb_add(unsigned* p, unsigned v) { return __hip_atomic_fetch_add(p, v, __ATOMIC_RELAXED, __HIP_MEMORY_SCOPE_AGENT); }
__device__ __forceinline__ unsigned xb_xcc_id() { return (unsigned)__builtin_amdgcn_s_getreg((3 << 11) | 20) & 0xFu; }
#define XB_SPIN(cond, bar) do { unsigned _sp = 0; while (cond) { __builtin_amdgcn_s_sleep(1); \
    if ((++_sp & 255u) == 0u) { if (xb_ld(&(bar)[XB_TMO])) break; if (_sp > XB_SPIN_CAP) { atomicAdd(&(bar)[XB_TMO], 1u); break; } } } } while (0)

struct XcdBarrier {
    unsigned* bar; unsigned x;
    volatile LAS unsigned* st;
};

__device__ __forceinline__ XcdBarrier xcd_barrier_post(unsigned* bar, volatile LAS unsigned* st) {
    XcdBarrier b; b.bar = bar; b.x = xb_xcc_id(); b.st = st;
    if (threadIdx.x == 0) (void)xb_add(&bar[XB_XCNT(b.x)], 1u);
    return b;
}
__device__ __forceinline__ void xcd_barrier_complete(unsigned* bar, unsigned x, unsigned& nloc, unsigned& nx) {
    const unsigned G = gridDim.x * gridDim.y * gridDim.z;
    unsigned sum, cnt, mine, sp = 0u;
    for (;;) {
        sum = 0u; cnt = 0u; mine = 0u;
#pragma unroll
        for (unsigned j = 0; j < 16; ++j) { const unsigned c = xb_ld(&bar[XB_XCNT(j)]); sum += c; cnt += (c > 0u) ? 1u : 0u; mine = (j == x) ? c : mine; }
        if (sum == G) break;
        __builtin_amdgcn_s_sleep(1);
        if ((++sp & 255u) == 0u) { if (xb_ld(&bar[XB_TMO])) break; if (sp > XB_SPIN_CAP) { atomicAdd(&bar[XB_TMO], 1u); break; } }
    }
    nloc = mine > 0u ? mine : 1u; nx = cnt > 0u ? cnt : 1u;
}

__device__ __forceinline__ void xcd_barrier(const XcdBarrier& b) {
    asm volatile("s_waitcnt vmcnt(0)" ::: "memory");
    __syncthreads();
    if (threadIdx.x == 0) {
        unsigned* bar = b.bar;
        __builtin_amdgcn_s_waitcnt(0);
        unsigned nloc = b.st[0], nx = b.st[1];
        if (nloc == 0u) { xcd_barrier_complete(bar, b.x, nloc, nx); b.st[0] = nloc; b.st[1] = nx; }
        const unsigned old = xb_add(&bar[XB_XSUB(b.x)], 1u);
        const unsigned gen = old / nloc;
        if (old + 1u == (gen + 1u) * nloc) {
            __builtin_amdgcn_fence(__ATOMIC_RELEASE, "agent");
            asm volatile("s_waitcnt vmcnt(0)" ::: "memory");
            const unsigned og = xb_add(&bar[XB_TOP], 1u);
            const unsigned tg = og / nx;
            if (og + 1u == (tg + 1u) * nx) xb_add(&bar[XB_TOPGEN], 1u);
            else XB_SPIN(xb_ld(&bar[XB_TOPGEN]) == tg, bar);
            __builtin_amdgcn_fence(__ATOMIC_ACQUIRE, "agent");
            xb_add(&bar[XB_XGEN(b.x)], 1u);
            asm volatile("s_waitcnt vmcnt(0)" ::: "memory");
        } else {
            XB_SPIN(xb_ld(&bar[XB_XGEN(b.x)]) == gen, bar);
            __builtin_amdgcn_fence(__ATOMIC_ACQUIRE, "agent");
            asm volatile("s_waitcnt vmcnt(0)" ::: "memory");
        }
    }
    __syncthreads();
}

struct Args {
    const float* in[22]; float* out; unsigned char* ws; int ph_lo, ph_hi;
};

template <class RowMap>
__device__ __forceinline__ void transpose_item(const float* W, int K, int N, bf16* WT, LAS float* scr, int item, int lane, RowMap rm) {
    const int nblk = N / 32, kb = item / nblk, nb = item % nblk, k0 = 64 * kb, n0 = 32 * nb;
#pragma unroll 8
    for (int i = 0; i < 32; ++i) { const int kk = 2 * i + (lane >> 5); scr[kk * 33 + (lane & 31)] = W[(size_t)(k0 + kk) * N + n0 + (lane & 31)]; }
    asm volatile("s_waitcnt lgkmcnt(0)" ::: "memory");
    const int c = lane & 7;
#pragma unroll
    for (int j = 0; j < 4; ++j) { const int n = (lane >> 3) + 8 * j; const LAS float* s = scr + (8 * c) * 33 + n;
        v4u o; o.x = pk2(s[0 * 33], s[1 * 33]); o.y = pk2(s[2 * 33], s[3 * 33]); o.z = pk2(s[4 * 33], s[5 * 33]); o.w = pk2(s[6 * 33], s[7 * 33]);
        *(v4u*)(WT + (size_t)rm(n0 + n) * K + k0 + 8 * c) = o; }
    asm volatile("s_waitcnt lgkmcnt(0)" ::: "memory");
}
struct RmId { __device__ __forceinline__ int operator()(int n) const { return n; } };
struct RmGU { int sel; __device__ __forceinline__ int operator()(int n) const { return (n >> 7) * 256 + sel * 128 + (n & 127); } };
struct RmUq { __device__ __forceinline__ int operator()(int n) const { const int h = n / 192, off = n % 192; if (off < 128) return n; int i = off - 128; int pos;
        if (i < 32) pos = 8 * (i >> 2) + (i & 3); else { i -= 32; pos = 8 * (i >> 2) + 4 + (i & 3); } return 192 * h + 128 + pos; } };

__device__ __forceinline__ int t5_bucket(int dist) {
    if (dist < 16) return dist;
    const float v = __logf((float)dist * (1.0f / 16.0f)) * (16.0f / 2.0794415416798357f);
    int b = 16 + (int)v; return b > 31 ? 31 : b;
}

__global__ void __launch_bounds__(NWAVES * 64, 2) fwd_kernel(Args args) {
    extern __shared__ __attribute__((aligned(16))) unsigned char lds_raw[];
    LAS unsigned char* lds = (LAS unsigned char*)lds_raw;
    const int tid = threadIdx.x, lane = tid & 63, wave = __builtin_amdgcn_readfirstlane(tid >> 6);
    const int G = gridDim.x, bx = blockIdx.x;
    const int vcu = (G % 8 == 0) ? (bx % 8) * (G / 8) + bx / 8 : bx;
    const int gw = vcu * NWAVES + wave, NGW = G * NWAVES;
    unsigned char* ws = args.ws;
    const float* x_in = args.in[0]; const float* c_in = args.in[1]; const float* w_mod = args.in[2]; const float* b_mod = args.in[3];
    const float* norm_ffn1 = args.in[4]; const float* ffn1_gate = args.in[5]; const float* ffn1_up = args.in[6]; const float* ffn1_down = args.in[7];
    const float* norm_mix = args.in[8]; const float* w_in = args.in[9]; const float* q_norm = args.in[10]; const float* kv_norm = args.in[11];
    const float* w_uq = args.in[12]; const float* w_ukv = args.in[13]; const float* sinks = args.in[14]; const float* w_o = args.in[15];
    const float* norm_ffn2 = args.in[16]; const float* ffn2_gate = args.in[17]; const float* ffn2_up = args.in[18]; const float* ffn2_down = args.in[19];
    const float* rel_bias = args.in[20]; const float* norm_final = args.in[21];
    float* X = args.out;
    float* MOD = (float*)(ws + WS_MOD); float* ROPE = (float*)(ws + WS_ROPE);
    bf16* W1GU = (bf16*)(ws + WS_W1GU); bf16* W1D = (bf16*)(ws + WS_W1D); bf16* W2GU = (bf16*)(ws + WS_W2GU); bf16* W2D = (bf16*)(ws + WS_W2D);
    bf16* WIN = (bf16*)(ws + WS_WIN); bf16* WO = (bf16*)(ws + WS_WO); bf16* WUQ = (bf16*)(ws + WS_WUQ); bf16* WUKV = (bf16*)(ws + WS_WUKV);
    bf16* H = (bf16*)(ws + WS_H); bf16* ACT = (bf16*)(ws + WS_ACT); bf16* PROJ = (bf16*)(ws + WS_PROJ); bf16* Qb = (bf16*)(ws + WS_Q);
    bf16* KV = (bf16*)(ws + WS_KV); bf16* MIX = (bf16*)(ws + WS_MIX); bf16* QN = (bf16*)(ws + WS_QN); bf16* KVN = (bf16*)(ws + WS_KVN); bf16* KR = (bf16*)(ws + WS_KR);

    volatile LAS unsigned* MISC = (volatile LAS unsigned*)(lds + 131072 + 320);
    for (int u = tid; u < (LDS_BYTES - 131072) / 4; u += NWAVES * 64) ((LAS unsigned*)(lds + 131072))[u] = 0u;
    __syncthreads();
    XcdBarrier bar = xcd_barrier_post((unsigned*)(ws + WS_CTL) + 4096, MISC + 8);
    const int lo = args.ph_lo, hi = args.ph_hi;
#ifndef PH_MASK
#define PH_MASK 0xFFFFFFFFu
#endif
#define IN(k) (((PH_MASK >> (k)) & 1u) && lo <= (k) && (k) < hi)
#ifndef PROBE_DBL
#define PROBE_DBL 0u
#endif
#ifndef PROBE_SYNCS
#define PROBE_SYNCS 0
#endif
#define PHASE(k) for (int rep_ = 0; rep_ < (IN(k) ? 1 + (int)((PROBE_DBL >> (k)) & 1u) : 0); ++rep_)
#define SEAM(k) do { if (IN(k) && IN((k) + 1)) xcd_barrier(bar); } while (0)

    PHASE(0) {
        for (int u = bx; u < (N_MOD * D_MODEL) / 64; u += G) {
            LAS float* sact = (LAS float*)lds;
            LAS float* part = (LAS float*)(lds + 32768);
            for (int i = tid; i < BATCH * D_MODEL; i += NWAVES * 64) { const float v = c_in[i]; sact[i] = v / (1.0f + __expf(-v)); }
            __syncthreads();
            const int n = 64 * u + lane; float acc[8];
#pragma unroll
            for (int b = 0; b < 8; ++b) acc[b] = 0.f;
            const float* wp = w_mod + (size_t)(128 * wave) * (N_MOD * D_MODEL) + n;
#pragma unroll 8
            for (int k = 0; k < 128; ++k) { const float wv = wp[(size_t)k * (N_MOD * D_MODEL)];
#pragma unroll
                for (int b = 0; b < 8; ++b) acc[b] = fmaf(sact[b * 1024 + 128 * wave + k], wv, acc[b]); }
#pragma unroll
            for (int b = 0; b < 8; ++b) part[(wave * 8 + b) * 64 + lane] = acc[b];
            __syncthreads();
            { const int b = tid >> 6; float s = 0.f;
#pragma unroll
              for (int w = 0; w < 8; ++w) s += part[(w * 8 + b) * 64 + lane];
              MOD[(size_t)b * (N_MOD * D_MODEL) + n] = s + b_mod[n]; }
            __syncthreads();
        }
        for (int idx = bx * (NWAVES * 64) + tid; idx < SEQ * 32; idx += G * NWAVES * 64) { const int p = idx >> 5, i = idx & 31;
            const float inv = powf(10000.0f, -(float)(2 * i) / 64.0f); const float ang = (float)p * inv;
            ROPE[2 * idx] = cosf(ang); ROPE[2 * idx + 1] = sinf(ang); }
        LAS float* scr = (LAS float*)(lds + wave * 16384);
        constexpr int I_GU = (D_MODEL / 64) * (D_FF / 32), I_D = (D_FF / 64) * (D_MODEL / 32), I_IN = (D_MODEL / 64) * (D_IN / 32), I_O = (D_MODEL / 64) * (D_MODEL / 32),
                      I_UQ = (256 / 64) * (768 / 32), I_UKV = (128 / 64) * (1024 / 32);
        constexpr int NITEMS = 4 * I_GU + 2 * I_D + I_IN + I_O + I_UQ + I_UKV;
        for (int it = gw; it < NITEMS; it += NGW) {
            int r = it;
            if (r < I_GU) { transpose_item(ffn1_gate, D_MODEL, D_FF, W1GU, scr, r, lane, RmGU{0}); continue; } r -= I_GU;
            if (r < I_GU) { transpose_item(ffn1_up, D_MODEL, D_FF, W1GU, scr, r, lane, RmGU{1}); continue; } r -= I_GU;
            if (r < I_GU) { transpose_item(ffn2_gate, D_MODEL, D_FF, W2GU, scr, r, lane, RmGU{0}); continue; } r -= I_GU;
            if (r < I_GU) { transpose_item(ffn2_up, D_MODEL, D_FF, W2GU, scr, r, lane, RmGU{1}); continue; } r -= I_GU;
            if (r < I_D) { transpose_item(ffn1_down, D_FF, D_MODEL, W1D, scr, r, lane, RmId{}); continue; } r -= I_D;
            if (r < I_D) { transpose_item(ffn2_down, D_FF, D_MODEL, W2D, scr, r, lane, RmId{}); continue; } r -= I_D;
            if (r < I_IN) { transpose_item(w_in, D_MODEL, D_IN, WIN, scr, r, lane, RmId{}); continue; } r -= I_IN;
            if (r < I_O) { transpose_item(w_o, D_MODEL, D_MODEL, WO, scr, r, lane, RmId{}); continue; } r -= I_O;
            if (r < I_UQ) { transpose_item(w_uq, 256, 768, WUQ, scr, r, lane, RmUq{}); continue; } r -= I_UQ;
            transpose_item(w_ukv, 128, 1024, WUKV, scr, r, lane, RmId{});
        }
        for (int i = bx * (NWAVES * 64) + tid; i < (D_IN_PAD - D_IN) * D_MODEL / 8; i += G * NWAVES * 64) ((v4u*)(WIN + (size_t)D_IN * D_MODEL))[i] = (v4u){0u, 0u, 0u, 0u};
    }
    SEAM(0);
    for (int es_ = 0; es_ < PROBE_SYNCS; ++es_) xcd_barrier(bar);

    auto modnorm = [&](const float* src, const float* gain, int chunk) {
        for (int r8 = gw; r8 < M / 8; r8 += NGW) {
            const int row0 = r8 * 8, b = row0 / SEQ;
            const float* shp = MOD + (size_t)b * (N_MOD * D_MODEL) + (size_t)chunk * D_MODEL; const float* scp = shp + D_MODEL;
            f32x4 gg[4], sh[4];
#pragma unroll
            for (int j = 0; j < 4; ++j) { const f32x4 g = ((const f32x4*)gain)[lane + 64 * j], sc = ((const f32x4*)scp)[lane + 64 * j]; gg[j] = g * (1.0f + sc); sh[j] = ((const f32x4*)shp)[lane + 64 * j]; }
            for (int rr = 0; rr < 8; ++rr) { const int row = row0 + rr;
                const f32x4* xr = (const f32x4*)(src + (size_t)row * D_MODEL) + lane;
                f32x4 v[4]; float s = 0.f;
#pragma unroll
                for (int j = 0; j < 4; ++j) { v[j] = xr[64 * j]; s += (v[j].x * v[j].x + v[j].y * v[j].y) + (v[j].z * v[j].z + v[j].w * v[j].w); }
                const float rstd = 1.0f / sqrtf(wave_sum(s) * (1.0f / D_MODEL) + EPS);
                unsigned long long* o8 = (unsigned long long*)(H + (size_t)row * D_MODEL) + lane;
#pragma unroll
                for (int j = 0; j < 4; ++j) { const f32x4 y = v[j] * rstd * gg[j] + sh[j];
                    o8[64 * j] = (unsigned long long)pk2(y.x, y.y) | ((unsigned long long)pk2(y.z, y.w) << 32); } }
        }
    };

    PHASE(1) modnorm(x_in, norm_ffn1, 0);
    SEAM(1);
    PHASE(2) { pg8::Gemm g{H, W1GU, M, 2 * D_FF, D_MODEL}; pg8::StaticOrder S; S.init(M, 2 * D_FF, G, bx); pg8::EpiSwiglu E{ACT, D_FF};
        pg8::gemm_phase<pg8::EpiSwiglu, pg8::StaticOrder, true, true>(lds, g, S, E); }
    SEAM(2);
    PHASE(3) { pg8::Gemm g{ACT, W1D, M, D_MODEL, D_FF}; pg8::StaticOrder S; S.init(M, D_MODEL, G, bx); pg8::EpiResid E{x_in, X, MOD + 2 * D_MODEL, 0.5f};
        pg8::gemm_phase<pg8::EpiResid, pg8::StaticOrder, true, true>(lds, g, S, E); }
    SEAM(3);
    PHASE(4) modnorm(X, norm_mix, 3);
    SEAM(4);
    PHASE(5) { pg8::Gemm g{H, WIN, M, D_IN_PAD, D_MODEL}; pg8::StaticOrder S; S.init(M, D_IN_PAD, G, bx); pg8::EpiBf16 E{PROJ, D_IN_PAD};
        pg8::gemm_phase<pg8::EpiBf16, pg8::StaticOrder, true, true>(lds, g, S, E); }
    SEAM(5);
    PHASE(6) {
        const f32x4 qg = ((const f32x4*)q_norm)[lane]; const float kg0 = kv_norm[2 * lane], kg1 = kv_norm[2 * lane + 1];
        for (int row = gw; row < M; row += NGW) {
            const bf16* pr = PROJ + (size_t)row * D_IN_PAD;
            const unsigned long long qraw = ((const unsigned long long*)(pr + 768))[lane]; const unsigned kraw = ((const unsigned*)(pr + 1024))[lane]; const unsigned short rraw = pr[1152 + lane];
            const float q0 = bf2f((unsigned short)qraw), q1 = bf2f((unsigned short)(qraw >> 16)), q2 = bf2f((unsigned short)(qraw >> 32)), q3 = bf2f((unsigned short)(qraw >> 48));
            const float k0 = bf2f((unsigned short)kraw), k1 = bf2f((unsigned short)(kraw >> 16)); const float xr = bf2f(rraw);
            const float qs = wave_sum((q0 * q0 + q1 * q1) + (q2 * q2 + q3 * q3)), ks = wave_sum(k0 * k0 + k1 * k1);
            const float qr = 1.0f / sqrtf(qs * (1.0f / 256.0f) + EPS), kr = 1.0f / sqrtf(ks * (1.0f / 128.0f) + EPS);
            ((unsigned long long*)(QN + (size_t)row * 256))[lane] = (unsigned long long)pk2(q0 * qr * qg.x, q1 * qr * qg.y) | ((unsigned long long)pk2(q2 * qr * qg.z, q3 * qr * qg.w) << 32);
            ((unsigned*)(KVN + (size_t)row * 128))[lane] = pk2(k0 * kr * kg0, k1 * kr * kg1);
            const float other = __shfl_xor(xr, 32); const int i = lane & 31; const int pos = row & (SEQ - 1);
            const float co = ROPE[(pos * 32 + i) * 2], si = ROPE[(pos * 32 + i) * 2 + 1];
            const float y = (lane < 32) ? (xr * co - other * si) : (xr * co + other * si);
            const int dst = 8 * (i >> 2) + (i & 3) + ((lane < 32) ? 0 : 4);
            KR[(size_t)row * 64 + dst] = (bf16)f2bf(y);
        }
    }
    SEAM(6);
    PHASE(7) {
#ifndef NO_QG
        { pg8::Gemm g{QN, WUQ, M, 768, 256}; pg8::StaticOrder S; S.init(M, 768, G, bx); pg8::EpiQRope E{Qb, 768, ROPE, 0.07216878364870322f * L2E};
          pg8::gemm_phase<pg8::EpiQRope, pg8::StaticOrder, true, true>(lds, g, S, E); }
#endif
#ifndef NO_KVG
        { pg8::Gemm g{KVN, WUKV, M, 1024, 128}; pg8::StaticOrder S; S.init(M, 1024, G, bx); pg8::EpiBf16 E{KV, 1024};
          pg8::gemm_phase<pg8::EpiBf16, pg8::StaticOrder, true, true>(lds, g, S, E); }
#endif
    }
    SEAM(7);
    PHASE(8) {
        LAS char* alds = (LAS char*)lds;
        {
            typedef att::Body<128, 64, 128, false> B;
            static_assert(B::LDS_TOTAL <= LDS_BYTES, "MLA LDS");
            for (int u = vcu; u < BATCH * 4 * 8; u += G) { const int bh = u >> 3, y = 7 - (u & 7), b = bh >> 2, h = bh & 3;
                const int r0 = (wave < 4) ? (128 * y + 32 * wave) : (128 * (15 - y) + 32 * (wave - 4));
                const size_t rb = (size_t)b * SEQ;
                B::unit(alds, Qb + (rb + r0) * 768 + 192 * h, 768, KV + rb * 1024 + 256 * h, 1024, KR + rb * 64, 64, KV + rb * 1024 + 256 * h + 128, 1024,
                        MIX + (rb + r0) * 1024 + 512 + 128 * h, 1024, r0, 0, 32 - 2 * y, 0x7fffffffu, 1.0f, 0.f); }
        }
        {
            typedef att::Body<64, 0, 64, true> B;
            static_assert(B::LDS_TOTAL <= LDS_BYTES, "SWA LDS");
            for (int u = vcu; u < BATCH * 8 * 8; u += G) { const int bh = u >> 3, qb = u & 7, b = bh >> 3, h = bh & 7, gkv = h >> 2;
                LAS float* tb = (LAS float*)(alds + B::OFF_BIAS);
                if (tid < 384) { const int dist = 256 - tid; tb[tid] = (dist >= 0 && dist < 128) ? rel_bias[t5_bucket(dist) * 8 + h] * L2E : 0.f; }
                const int r0 = 256 * qb + 32 * wave; const int kb0 = qb == 0 ? 0 : 256 * qb - 128; const int NT = (256 * qb + 256 - kb0) / 64;
                const size_t rb = (size_t)b * SEQ;
                B::unit(alds, PROJ + (rb + r0) * D_IN_PAD + 64 * h, D_IN_PAD, PROJ + rb * D_IN_PAD + 512 + 64 * gkv, D_IN_PAD, nullptr, 0, PROJ + rb * D_IN_PAD + 640 + 64 * gkv, D_IN_PAD,
                        MIX + (rb + r0) * 1024 + 64 * h, 1024, r0, kb0, NT, 128u, 0.125f * L2E, sinks[h] * L2E); }
        }
    }
    SEAM(8);
    PHASE(9) { pg8::Gemm g{MIX, WO, M, D_MODEL, D_MODEL}; pg8::StaticOrder S; S.init(M, D_MODEL, G, bx); pg8::EpiResid E{X, X, MOD + 5 * D_MODEL, 1.0f};
        pg8::gemm_phase<pg8::EpiResid, pg8::StaticOrder, true, true>(lds, g, S, E); }
    SEAM(9);
    PHASE(10) modnorm(X, norm_ffn2, 6);
    SEAM(10);
    PHASE(11) { pg8::Gemm g{H, W2GU, M, 2 * D_FF, D_MODEL}; pg8::StaticOrder S; S.init(M, 2 * D_FF, G, bx); pg8::EpiSwiglu E{ACT, D_FF};
        pg8::gemm_phase<pg8::EpiSwiglu, pg8::StaticOrder, true, true>(lds, g, S, E); }
    SEAM(11);
    PHASE(12) { pg8::Gemm g{ACT, W2D, M, D_MODEL, D_FF}; pg8::StaticOrder S; S.init(M, D_MODEL, G, bx); pg8::EpiResid E{X, X, MOD + 8 * D_MODEL, 0.5f};
        pg8::gemm_phase<pg8::EpiResid, pg8::StaticOrder, true, true>(lds, g, S, E); }
    SEAM(12);
    PHASE(13) {
        f32x4 gg[4];
#pragma unroll
        for (int j = 0; j < 4; ++j) gg[j] = ((const f32x4*)norm_final)[lane + 64 * j];
        for (int row = gw; row < M; row += NGW) { f32x4* xr = (f32x4*)(X + (size_t)row * D_MODEL) + lane; f32x4 v[4]; float s = 0.f;
#pragma unroll
            for (int j = 0; j < 4; ++j) { v[j] = xr[64 * j]; s += (v[j].x * v[j].x + v[j].y * v[j].y) + (v[j].z * v[j].z + v[j].w * v[j].w); }
            const float rstd = 1.0f / sqrtf(wave_sum(s) * (1.0f / D_MODEL) + EPS);
#pragma unroll
            for (int j = 0; j < 4; ++j) xr[64 * j] = v[j] * rstd * gg[j]; }
    }
#undef IN
#undef SEAM
#undef PHASE
}

constexpr int N_PHASES = 14;

extern "C" void kernel_launch(void* const* d_in, const int* in_sizes, int n_in, void* d_out, int out_size, void* d_ws, size_t ws_size, hipStream_t stream) {
    static int grid = 0;
    if (grid == 0) {
        if (n_in != 22 || out_size != M * D_MODEL || ws_size < WS_END) { fprintf(stderr, "kernel_launch: unexpected shapes (n_in %d out %d ws %zu)\n", n_in, out_size, ws_size); grid = -1; return; }
        int dev = 0, cus = 0, per_cu = 0;
        hipGetDevice(&dev); hipDeviceGetAttribute(&cus, hipDeviceAttributeMultiprocessorCount, dev);
        if (hipFuncSetAttribute((const void*)fwd_kernel, hipFuncAttributeMaxDynamicSharedMemorySize, LDS_BYTES) != hipSuccess) { fprintf(stderr, "kernel_launch: hipFuncSetAttribute failed\n"); grid = -1; return; }
        if (hipOccupancyMaxActiveBlocksPerMultiprocessor(&per_cu, (const void*)fwd_kernel, NWAVES * 64, LDS_BYTES) != hipSuccess || per_cu < 1) { fprintf(stderr, "kernel_launch: occupancy query says %d\n", per_cu); grid = -1; return; }
        grid = cus;
    }
    if (grid < 0) return;
    if (hipMemsetAsync((char*)d_ws + WS_CTL, 0, 65536, stream) != hipSuccess) { fprintf(stderr, "kernel_launch: memset failed\n"); return; }
    Args a{};
    for (int i = 0; i < 22; ++i) a.in[i] = (const float*)d_in[i];
    a.out = (float*)d_out; a.ws = (unsigned char*)d_ws; a.ph_lo = 0; a.ph_hi = N_PHASES;
    void* kargs[] = {&a};
    hipError_t e = hipLaunchCooperativeKernel((const void*)fwd_kernel, dim3(grid), dim3(NWAVES * 64), kargs, LDS_BYTES, stream);
    if (e != hipSuccess) fprintf(stderr, "cooperative launch failed: %s (grid %d)\n", hipGetErrorString(e), grid);
}
```

```cpp
#include <hip/hip_runtime.h>
#include <cstdio>
#include <cstdint>

namespace pg8 {
#define PG8_LAS __attribute__((address_space(3)))
typedef unsigned short bf16_t;
typedef short bf16x8 __attribute__((ext_vector_type(8)));
typedef float f32x4 __attribute__((ext_vector_type(4)));
typedef unsigned u32x4 __attribute__((ext_vector_type(4)));
constexpr int BM = 256, BK = 64, HALF = 128, HTB = HALF * BK * 2  , STAGE_BYTES = 8 * HTB, NXCD = 8, WGM = 8;

__host__ __device__ __forceinline__ int lds_byte(int r, int c) { const int st = (r >> 4) * 2 + (c >> 5), rr = r & 15, cc = c & 31, ob = rr * 64 + cc * 2; return st * 1024 + (ob ^ (((ob >> 9) & 1) << 5)); }
__host__ __device__ __forceinline__ void stage_rc(int b, int& R, int& C) { const int st = b / 1024, sb = b % 1024, swz = sb ^ (((sb >> 9) & 1) << 5); R = (st >> 1) * 16 + swz / 64; C = (st & 1) * 32 + (swz % 64) / 2; }
__host__ __device__ __forceinline__ int perm32(int rho) { const int n = rho >> 4, i = rho & 15; return 8 * (i >> 2) + 4 * n + (i & 3); }

struct Unit { int pm, pn; };
struct Gemm { const bf16_t* A; const bf16_t* Bt; int M, N, K, lda; };

struct StaticOrder {
    int nM, nN, nwg, G, c;
    __host__ __device__ void init(int M, int N, int G_, int c_) { nM = M / BM; nN = N / BM; nwg = nM * nN; G = G_; c = c_; }
    __host__ __device__ bool next(int i, Unit& u) const {
        const long L = (long)i * G + c; if (L >= nwg) return false;
        int wgid = (int)L; { const int q = nwg / NXCD, r = nwg % NXCD, xcd = wgid % NXCD, off = wgid / NXCD; wgid = (xcd < r ? xcd * (q + 1) : r * (q + 1) + (xcd - r) * q) + off; }
        const int nig = WGM * nN, gid = wgid / nig, fm = gid * WGM, gsz = (nM - fm) < WGM ? (nM - fm) : WGM;
        u.pm = fm + ((wgid % nig) % gsz); u.pn = (wgid % nig) / gsz; return true;
    }
    __device__ __forceinline__ void a_ready(const Unit&) const {}
    __device__ __forceinline__ void done(const Unit&) const {}
};

__device__ __forceinline__ unsigned cvt_pk_bf16(float lo, float hi) { unsigned r; asm volatile("v_cvt_pk_bf16_f32 %0, %1, %2" : "=v"(r) : "v"(lo), "v"(hi)); return r; }

__device__ __forceinline__ float rstd16(const float* st, int row, float inv_n, float eps) {
    const f32x4* p = (const f32x4*)(st + (size_t)row * 16); const f32x4 a = p[0], b = p[1], c = p[2], d = p[3];
    const float s = ((a[0] + a[1]) + (a[2] + a[3])) + ((b[0] + b[1]) + (b[2] + b[3])) + ((c[0] + c[1]) + (c[2] + c[3])) + ((d[0] + d[1]) + (d[2] + d[3]));
    return 1.0f / sqrtf(s * inv_n + eps);
}
__device__ __forceinline__ float rstd4(const float* st, int row, float inv_n, float eps) {
    const f32x4 a = *(const f32x4*)(st + (size_t)row * 4); return 1.0f / sqrtf(((a[0] + a[1]) + (a[2] + a[3])) * inv_n + eps);
}
__device__ __forceinline__ float quad_sum(float s) { s += __shfl_xor(s, 16); s += __shfl_xor(s, 32); return s; }

typedef float f32x2e __attribute__((ext_vector_type(2)));
template <int NP> __device__ __forceinline__ void panel_rstd(const float* stat, int pm, float inv_n, PG8_LAS float* rsl) {
    const int t = threadIdx.x, r = t >> 1, h = t & 1; const float* p = stat + (size_t)(pm * BM + r) * NP + h * (NP / 2); float s;
    if constexpr (NP == 16) { const f32x4 a = *(const f32x4*)p, b = *(const f32x4*)(p + 4); s = ((a[0] + a[1]) + (a[2] + a[3])) + ((b[0] + b[1]) + (b[2] + b[3])); }
    else { const f32x2e a = *(const f32x2e*)p; s = a[0] + a[1]; }
    s += __shfl_xor(s, 1);
    if (h == 0) rsl[r] = 1.0f / sqrtf(s * inv_n + 1e-6f);
    asm volatile("s_waitcnt lgkmcnt(0)" ::: "memory"); __builtin_amdgcn_s_barrier(); asm volatile("" ::: "memory");
}
template <bool RS> struct EpiBf16 {
    static constexpr bool PERM = true, AFTER_DRAIN = false;
    bf16_t* O; const float* stat; PG8_LAS float* rsl; int ldc; float inv_n;
    __device__ __forceinline__ void operator()(const f32x4 (&acc)[2][2][4][2], const Unit& u, int wr, int wc, int fr, int fq) const {
        const int row0 = u.pm * BM + wr * 64 + fr; const int col0 = u.pn * BM + wc * 32 + 8 * fq;
        if constexpr (RS) panel_rstd<4>(stat, u.pm, inv_n, rsl);
#pragma unroll
        for (int ai = 0; ai < 2; ++ai)
#pragma unroll
            for (int m = 0; m < 4; ++m) { const int row = row0 + ai * HALF + m * 16; bf16_t* rowp = O + (size_t)row * ldc + col0;
                float rs = 1.0f; if constexpr (RS) rs = rsl[wr * 64 + fr + ai * HALF + m * 16];
#pragma unroll
                for (int bj = 0; bj < 2; ++bj) { const f32x4 v0 = acc[ai][bj][m][0] * rs, v1 = acc[ai][bj][m][1] * rs;
                    u32x4 w; w.x = cvt_pk_bf16(v0[0], v0[1]); w.y = cvt_pk_bf16(v0[2], v0[3]); w.z = cvt_pk_bf16(v1[0], v1[1]); w.w = cvt_pk_bf16(v1[2], v1[3]);
                    *(u32x4*)(rowp + bj * HALF) = w; } }
    }
};
__device__ __forceinline__ float silu_f(float x) { return x * __builtin_amdgcn_rcpf(1.0f + __expf(-x)); }
template <bool DEFER> struct EpiSwiglu {
    static constexpr bool PERM = true, AFTER_DRAIN = false;
    bf16_t* O; const float* stat; const float* bias; PG8_LAS float* rsl; int ldc;
    __device__ __forceinline__ void operator()(const f32x4 (&acc)[2][2][4][2], const Unit& u, int wr, int wc, int fr, int fq) const {
        const int row0 = u.pm * BM + wr * 64 + fr; const int col0 = u.pn * HALF + wc * 32 + 8 * fq;
        if constexpr (DEFER) panel_rstd<16>(stat, u.pm, 1.0f / 1024.0f, rsl);
        f32x4 bg0 = {0.f, 0.f, 0.f, 0.f}, bg1 = bg0, bu0 = bg0, bu1 = bg0;
        if constexpr (DEFER) { const float* bp = bias + (size_t)(u.pm >> 3) * (22 * 256) + u.pn * BM + wc * 32 + 8 * fq;
            bg0 = *(const f32x4*)bp; bg1 = *(const f32x4*)(bp + 4); bu0 = *(const f32x4*)(bp + HALF); bu1 = *(const f32x4*)(bp + HALF + 4); }
#pragma unroll
        for (int ai = 0; ai < 2; ++ai)
#pragma unroll
            for (int m = 0; m < 4; ++m) { const int row = row0 + ai * HALF + m * 16; bf16_t* rowp = O + (size_t)row * ldc + col0;
                f32x4 g0 = acc[ai][0][m][0], g1 = acc[ai][0][m][1], u0 = acc[ai][1][m][0], u1 = acc[ai][1][m][1];
                if constexpr (DEFER) { const float rs = rsl[wr * 64 + fr + ai * HALF + m * 16]; g0 = g0 * rs + bg0; g1 = g1 * rs + bg1; u0 = u0 * rs + bu0; u1 = u1 * rs + bu1; }
                float a[8];
#pragma unroll
                for (int j = 0; j < 4; ++j) { a[j] = silu_f(g0[j]) * u0[j]; a[4 + j] = silu_f(g1[j]) * u1[j]; }
                u32x4 w; w.x = cvt_pk_bf16(a[0], a[1]); w.y = cvt_pk_bf16(a[2], a[3]); w.z = cvt_pk_bf16(a[4], a[5]); w.w = cvt_pk_bf16(a[6], a[7]);
                *(u32x4*)rowp = w; }
    }
};
template <bool NEXT> struct EpiResid {
    static constexpr bool PERM = true, AFTER_DRAIN = false;
    const float* base; float* out; const float* gate;
    const float* ngain; const float* nscale; bf16_t* XG; float* stat;
    float coef;
    __device__ __forceinline__ void operator()(const f32x4 (&acc)[2][2][4][2], const Unit& u, int wr, int wc, int fr, int fq) const {
        const int row0 = u.pm * BM + wr * 64 + fr; const int col0 = u.pn * BM + wc * 32 + 8 * fq; const int b = u.pm >> 3;
        f32x4 ss[2]; ss[0] = (f32x4){0.f, 0.f, 0.f, 0.f}; ss[1] = ss[0];
#pragma unroll
        for (int bj = 0; bj < 2; ++bj) { const int cc = col0 + bj * HALF; const float* gp = gate + (size_t)b * 9216 + cc;
            const f32x4 gv0 = *(const f32x4*)gp * coef, gv1 = *(const f32x4*)(gp + 4) * coef;
            f32x4 gn0 = {0.f, 0.f, 0.f, 0.f}, gn1 = gn0;
            if constexpr (NEXT) { const float* sp = nscale + (size_t)b * 9216 + cc; gn0 = *(const f32x4*)(ngain + cc) * (*(const f32x4*)sp + 1.0f); gn1 = *(const f32x4*)(ngain + cc + 4) * (*(const f32x4*)(sp + 4) + 1.0f); }
#pragma unroll
            for (int ai = 0; ai < 2; ++ai) { f32x4 bs0[4], bs1[4];
#pragma unroll
                for (int m = 0; m < 4; ++m) { const size_t off = (size_t)(row0 + ai * HALF + m * 16) * 1024 + cc; bs0[m] = *(const f32x4*)(base + off); bs1[m] = *(const f32x4*)(base + off + 4); }
#pragma unroll
                for (int m = 0; m < 4; ++m) { const size_t off = (size_t)(row0 + ai * HALF + m * 16) * 1024 + cc;
                    const f32x4 o0 = bs0[m] + gv0 * acc[ai][bj][m][0], o1 = bs1[m] + gv1 * acc[ai][bj][m][1];
                    *(f32x4*)(out + off) = o0; *(f32x4*)(out + off + 4) = o1;
                    if constexpr (NEXT) { ss[ai][m] += ((o0[0] * o0[0] + o0[1] * o0[1]) + (o0[2] * o0[2] + o0[3] * o0[3])) + ((o1[0] * o1[0] + o1[1] * o1[1]) + (o1[2] * o1[2] + o1[3] * o1[3]));
                        const f32x4 x0 = o0 * gn0, x1 = o1 * gn1; u32x4 w; w.x = cvt_pk_bf16(x0[0], x0[1]); w.y = cvt_pk_bf16(x0[2], x0[3]); w.z = cvt_pk_bf16(x1[0], x1[1]); w.w = cvt_pk_bf16(x1[2], x1[3]);
                        *(u32x4*)(XG + off) = w; } }
                asm volatile("" ::: "memory"); } }
        if constexpr (NEXT) {
#pragma unroll
            for (int ai = 0; ai < 2; ++ai)
#pragma unroll
                for (int m = 0; m < 4; ++m) { const float t = quad_sum(ss[ai][m]); if (fq == 0) stat[(size_t)(row0 + ai * HALF + m * 16) * 16 + u.pn * 4 + wc] = t; } }
    }
};
struct EpiProj {
    static constexpr bool PERM = true, AFTER_DRAIN = false;
    bf16_t* O; const float* stat; const float* bias; float* statq; float* statkv; bf16_t* KR; const float* cs; PG8_LAS float* rsl;
    __device__ __forceinline__ void operator()(const f32x4 (&acc)[2][2][4][2], const Unit& u, int wr, int wc, int fr, int fq) const {
        const int row0 = u.pm * BM + wr * 64 + fr; const int col0 = u.pn * BM + wc * 32 + 8 * fq;
        panel_rstd<16>(stat, u.pm, 1.0f / 1024.0f, rsl);
        const float* bp = bias + (size_t)(u.pm >> 3) * 1280 + col0;
        const f32x4 b00 = *(const f32x4*)bp, b01 = *(const f32x4*)(bp + 4), b10 = *(const f32x4*)(bp + HALF), b11 = *(const f32x4*)(bp + HALF + 4);
#pragma unroll
        for (int ai = 0; ai < 2; ++ai)
#pragma unroll
            for (int m = 0; m < 4; ++m) { const int row = row0 + ai * HALF + m * 16; const float rs = rsl[wr * 64 + fr + ai * HALF + m * 16];
                const f32x4 v00 = acc[ai][0][m][0] * rs + b00, v01 = acc[ai][0][m][1] * rs + b01, v10 = acc[ai][1][m][0] * rs + b10, v11 = acc[ai][1][m][1] * rs + b11;
                bf16_t* rowp = O + (size_t)row * 1280 + col0;
                { u32x4 w; w.x = cvt_pk_bf16(v00[0], v00[1]); w.y = cvt_pk_bf16(v00[2], v00[3]); w.z = cvt_pk_bf16(v01[0], v01[1]); w.w = cvt_pk_bf16(v01[2], v01[3]); *(u32x4*)rowp = w; }
                if (u.pn < 4) { u32x4 w; w.x = cvt_pk_bf16(v10[0], v10[1]); w.y = cvt_pk_bf16(v10[2], v10[3]); w.z = cvt_pk_bf16(v11[0], v11[1]); w.w = cvt_pk_bf16(v11[2], v11[3]); *(u32x4*)(rowp + HALF) = w; }
                if (u.pn >= 3) {
                    float s0 = 0.f, s1 = 0.f;
#pragma unroll
                    for (int j = 0; j < 4; ++j) { s0 += v00[j] * v00[j] + v01[j] * v01[j]; s1 += v10[j] * v10[j] + v11[j] * v11[j]; }
                    if (u.pn == 3) { const float t = quad_sum(s0 + s1); if (fq == 0) statq[(size_t)row * 4 + wc] = t; }
                    else { const float t = quad_sum(s0); if (fq == 0) statkv[(size_t)row * 4 + wc] = t;
                        if (wc < 2) { const int g = 4 * wc + fq; const float* c = cs + ((size_t)(row & 2047) * 32 + 4 * g) * 2; const f32x4 c01 = *(const f32x4*)c, c23 = *(const f32x4*)(c + 4);
                            const float co[4] = {c01[0], c01[2], c23[0], c23[2]}, si[4] = {c01[1], c01[3], c23[1], c23[3]}; float y1[4], y2[4];
#pragma unroll
                            for (int j = 0; j < 4; ++j) { const float x1 = v10[j], x2 = v11[j]; y1[j] = x1 * co[j] - x2 * si[j]; y2[j] = x2 * co[j] + x1 * si[j]; }
                            u32x4 w; w.x = cvt_pk_bf16(y1[0], y1[1]); w.y = cvt_pk_bf16(y1[2], y1[3]); w.z = cvt_pk_bf16(y2[0], y2[1]); w.w = cvt_pk_bf16(y2[2], y2[3]);
                            *(u32x4*)(KR + (size_t)row * 64 + 8 * g) = w; } } }
                asm volatile("" ::: "memory"); }
    }
};
struct EpiQRope {
    static constexpr bool PERM = true, AFTER_DRAIN = false;
    bf16_t* O; const float* cs; const float* statq; PG8_LAS float* rsl; int ldc; float qscale;
    __device__ __forceinline__ void operator()(const f32x4 (&acc)[2][2][4][2], const Unit& u, int wr, int wc, int fr, int fq) const {
        const int row0 = u.pm * BM + wr * 64 + fr;
        panel_rstd<4>(statq, u.pm, 1.0f / 256.0f, rsl);
#pragma unroll
        for (int bj = 0; bj < 2; ++bj) { const int col0 = u.pn * BM + bj * HALF + wc * 32 + 8 * fq; const int off = col0 % 192; const bool rope = off >= 128; const int g = rope ? ((off - 128) >> 3) : 0;
#pragma unroll
            for (int ai = 0; ai < 2; ++ai)
#pragma unroll
                for (int m = 0; m < 4; ++m) { const int row = row0 + ai * HALF + m * 16; f32x4 v0 = acc[ai][bj][m][0], v1 = acc[ai][bj][m][1];
                    const float qs = qscale * rsl[wr * 64 + fr + ai * HALF + m * 16];
                    const float* c = cs + ((size_t)(row & 2047) * 32 + 4 * g) * 2; f32x4 c01 = *(const f32x4*)c, c23 = *(const f32x4*)(c + 4);
                    if (!rope) { c01 = (f32x4){1.f, 0.f, 1.f, 0.f}; c23 = c01; }
                    const float co[4] = {c01[0], c01[2], c23[0], c23[2]}, si[4] = {c01[1], c01[3], c23[1], c23[3]};
#pragma unroll
                    for (int j = 0; j < 4; ++j) { const float x1 = v0[j], x2 = v1[j]; v0[j] = (x1 * co[j] - x2 * si[j]) * qs; v1[j] = (x2 * co[j] + x1 * si[j]) * qs; }
                    u32x4 w; w.x = cvt_pk_bf16(v0[0], v0[1]); w.y = cvt_pk_bf16(v0[2], v0[3]); w.z = cvt_pk_bf16(v1[0], v1[1]); w.w = cvt_pk_bf16(v1[2], v1[3]);
                    *(u32x4*)(O + (size_t)row * ldc + col0) = w;
                    asm volatile("" ::: "memory"); } }
    }
};

template <class Epi, class Sched, bool ALIGN_EPI = false, bool SP2 = false>
__device__ __forceinline__ void gemm_phase(PG8_LAS unsigned char* lds, const Gemm g, const Sched& S, const Epi& E) {
    const int tid = threadIdx.x, wid = __builtin_amdgcn_readfirstlane(tid >> 6), lane = tid & 63, wr = wid >> 2, wc = wid & 3, fr = lane & 15, fq = lane >> 4;
    int Kop = g.K; asm volatile("" : "+s"(Kop));
    const int K = Kop, nt = K / BK;
    unsigned voffA[2], voffB[2];
#pragma unroll
    for (int i = 0; i < 2; ++i) { int R, C; stage_rc(tid * 16 + i * 8192, R, C); const int Rb = Epi::PERM ? ((R & ~31) + perm32(R & 31)) : R;
        voffA[i] = (unsigned)(R * g.lda + C) * 2u; voffB[i] = (unsigned)(Rb * K + C) * 2u; }
    const size_t kstep = (size_t)(BK * 2);
    const size_t hstep = (size_t)HALF * K * 2;
    const size_t tstep = 2 * hstep;
    const size_t hstepA = (size_t)HALF * g.lda * 2, tstepA = 2 * hstepA;
    const unsigned ldsw = (unsigned)wid * 1024u;
    const int aoff = lds_byte(wr * 64 + fr, fq * 8), boff = lds_byte(wc * 32 + fr, fq * 8);
#define PG8_SA(b, h) (((b) * 2 + (h)) * HTB)
#define PG8_SB(b, h) ((4 + (b) * 2 + (h)) * HTB)
#define PG8_STAGE(bufoff, gbase, voff) do { _Pragma("unroll") for (int _i = 0; _i < 2; ++_i) \
        __builtin_amdgcn_global_load_lds((const unsigned*)((const char*)(gbase) + (voff)[_i]), (PG8_LAS unsigned*)(lds + (bufoff) + ldsw + _i * 8192), 16, 0, 0); } while (0)
#define PG8_LDA(dst, b, h) do { _Pragma("unroll") for (int m = 0; m < 4; ++m) _Pragma("unroll") for (int k = 0; k < 2; ++k) dst[m][k] = *(const PG8_LAS bf16x8*)(lds + PG8_SA(b, h) + aoff + m * 2048 + k * 1024); } while (0)
#define PG8_LDB(dst, b, h) do { _Pragma("unroll") for (int n = 0; n < 2; ++n) _Pragma("unroll") for (int k = 0; k < 2; ++k) dst[n][k] = *(const PG8_LAS bf16x8*)(lds + PG8_SB(b, h) + boff + n * 2048 + k * 1024); } while (0)
#define PG8_MMA(ai, bj, At, Bt) do { __builtin_amdgcn_s_setprio(1); _Pragma("unroll") for (int m = 0; m < 4; ++m) _Pragma("unroll") for (int n = 0; n < 2; ++n) _Pragma("unroll") for (int k = 0; k < 2; ++k) \
        acc[ai][bj][m][n] = __builtin_amdgcn_mfma_f32_16x16x32_bf16(Bt[n][k], At[m][k], acc[ai][bj][m][n], 0, 0, 0); __builtin_amdgcn_s_setprio(0); } while (0)
#define PG8_WAIT_V(n) asm volatile("s_waitcnt vmcnt(" #n ")" ::: "memory")
#define PG8_WAIT_L(n) asm volatile("s_waitcnt lgkmcnt(" #n ")" ::: "memory")
#define PG8_BAR __builtin_amdgcn_s_barrier()
#define PG8_SCHED __builtin_amdgcn_sched_barrier(0)
    Unit cur, nxt; int ui = 0;
    if (!S.next(0, cur)) return;
    f32x4 acc[2][2][4][2];
#pragma unroll
    for (int a = 0; a < 2; ++a)
#pragma unroll
        for (int b = 0; b < 2; ++b)
#pragma unroll
            for (int m = 0; m < 4; ++m)
#pragma unroll
                for (int n = 0; n < 2; ++n) acc[a][b][m][n] = (f32x4){0.f, 0.f, 0.f, 0.f};
    bf16x8 At[4][2], B0[2][2], B1[2][2];
    const char* cA = (const char*)g.A + (size_t)cur.pm * tstepA; const char* cB = (const char*)g.Bt + (size_t)cur.pn * tstep;
    S.a_ready(cur);
    if constexpr (SP2) {
        PG8_STAGE(PG8_SB(0, 0), cB, voffB); PG8_STAGE(PG8_SB(0, 1), cB + hstep, voffB); PG8_STAGE(PG8_SA(0, 0), cA, voffA); PG8_STAGE(PG8_SA(0, 1), cA + hstepA, voffA);
        if (wr == 1) PG8_BAR;
        PG8_WAIT_V(2); PG8_BAR;
        PG8_STAGE(PG8_SB(1, 0), cB + kstep, voffB); PG8_STAGE(PG8_SA(1, 0), cA + kstep, voffA); PG8_STAGE(PG8_SB(1, 1), cB + hstep + kstep, voffB);
        PG8_WAIT_V(6); PG8_BAR;
    } else {
        PG8_STAGE(PG8_SB(0, 0), cB, voffB); PG8_STAGE(PG8_SA(0, 0), cA, voffA); PG8_STAGE(PG8_SB(0, 1), cB + hstep, voffB); PG8_STAGE(PG8_SA(0, 1), cA + hstepA, voffA);
        if (wr == 1) PG8_BAR;
        PG8_WAIT_V(4); PG8_BAR;
        PG8_STAGE(PG8_SB(1, 0), cB + kstep, voffB); PG8_STAGE(PG8_SA(1, 0), cA + kstep, voffA); PG8_STAGE(PG8_SB(1, 1), cB + hstep + kstep, voffB);
        PG8_WAIT_V(6); PG8_BAR;
    }
    for (;;) {
        const bool has_next = S.next(ui + 1, nxt);
        const char* nA = has_next ? (const char*)g.A + (size_t)nxt.pm * tstepA : cA; const char* nB = has_next ? (const char*)g.Bt + (size_t)nxt.pn * tstep : cB;
        for (int t = 0; t < nt; t += 2) {
            const bool last = (t == nt - 2);
            const char* a1 = cA + (size_t)(t + 1) * kstep;
            const char* a2 = last ? nA : cA + (size_t)(t + 2) * kstep; const char* b2 = last ? nB : cB + (size_t)(t + 2) * kstep;
            const char* a3 = a2 + kstep; const char* b3 = b2 + kstep;
            if (last && has_next) S.a_ready(nxt);
            if constexpr (SP2) {
            PG8_LDB(B0, 0, 0); PG8_LDB(B1, 0, 1); PG8_SCHED; PG8_LDA(At, 0, 0); PG8_STAGE(PG8_SA(1, 1), a1 + hstepA, voffA);
            PG8_WAIT_V(8); PG8_WAIT_L(0); PG8_BAR; PG8_MMA(0, 0, At, B0); PG8_MMA(0, 1, At, B1); PG8_BAR; PG8_SCHED;
            PG8_LDA(At, 0, 1); PG8_STAGE(PG8_SB(0, 0), b2, voffB); PG8_STAGE(PG8_SB(0, 1), b2 + hstep, voffB); PG8_STAGE(PG8_SA(0, 0), a2, voffA);
            PG8_WAIT_V(8); PG8_WAIT_L(0); PG8_BAR; PG8_MMA(1, 0, At, B0); PG8_MMA(1, 1, At, B1); PG8_BAR; PG8_SCHED;
            PG8_LDB(B0, 1, 0); PG8_LDB(B1, 1, 1); PG8_SCHED; PG8_LDA(At, 1, 0); PG8_STAGE(PG8_SA(0, 1), a2 + hstepA, voffA);
            PG8_WAIT_V(8); PG8_WAIT_L(0); PG8_BAR; PG8_MMA(0, 0, At, B0); PG8_MMA(0, 1, At, B1); PG8_BAR; PG8_SCHED;
            PG8_LDA(At, 1, 1); PG8_STAGE(PG8_SB(1, 0), b3, voffB); PG8_STAGE(PG8_SB(1, 1), b3 + hstep, voffB); PG8_STAGE(PG8_SA(1, 0), a3, voffA);
            PG8_WAIT_V(8); PG8_WAIT_L(0); PG8_BAR; PG8_MMA(1, 0, At, B0); PG8_MMA(1, 1, At, B1); PG8_BAR; PG8_SCHED;
            } else {
            PG8_LDB(B0, 0, 0); PG8_SCHED; PG8_LDA(At, 0, 0); PG8_STAGE(PG8_SA(1, 1), a1 + hstepA, voffA);
            PG8_WAIT_L(8); PG8_BAR; PG8_WAIT_L(0); PG8_MMA(0, 0, At, B0); PG8_BAR; PG8_SCHED;
            PG8_LDB(B1, 0, 1); PG8_STAGE(PG8_SB(0, 0), b2, voffB);
            PG8_BAR; PG8_WAIT_L(0); PG8_MMA(0, 1, At, B1); PG8_BAR;
            PG8_LDA(At, 0, 1); PG8_STAGE(PG8_SA(0, 0), a2, voffA);
            PG8_BAR; PG8_WAIT_L(0); PG8_MMA(1, 0, At, B0); PG8_BAR; PG8_SCHED;
            PG8_STAGE(PG8_SB(0, 1), b2 + hstep, voffB);
            PG8_WAIT_V(6); PG8_BAR; PG8_MMA(1, 1, At, B1); PG8_BAR;
            PG8_LDB(B0, 1, 0); PG8_SCHED; PG8_LDA(At, 1, 0); PG8_STAGE(PG8_SA(0, 1), a2 + hstepA, voffA);
            PG8_WAIT_L(8); PG8_BAR; PG8_WAIT_L(0); PG8_MMA(0, 0, At, B0); PG8_BAR; PG8_SCHED;
            PG8_LDB(B1, 1, 1); PG8_STAGE(PG8_SB(1, 0), b3, voffB);
            PG8_BAR; PG8_WAIT_L(0); PG8_MMA(0, 1, At, B1); PG8_BAR;
            PG8_LDA(At, 1, 1); PG8_STAGE(PG8_SA(1, 0), a3, voffA);
            PG8_BAR; PG8_WAIT_L(0); PG8_MMA(1, 0, At, B0); PG8_BAR; PG8_SCHED;
            PG8_STAGE(PG8_SB(1, 1), b3 + hstep, voffB);
            PG8_WAIT_V(6); PG8_BAR; PG8_MMA(1, 1, At, B1); PG8_BAR;
            }
        }
        if constexpr (ALIGN_EPI) { if (wr == 0) PG8_BAR; }
        E(acc, cur, wr, wc, fr, fq); S.done(cur);
        if (!has_next) break;
#pragma unroll
        for (int a = 0; a < 2; ++a)
#pragma unroll
            for (int b = 0; b < 2; ++b)
#pragma unroll
                for (int m = 0; m < 4; ++m)
#pragma unroll
                    for (int n = 0; n < 2; ++n) acc[a][b][m][n] = (f32x4){0.f, 0.f, 0.f, 0.f};
        cur = nxt; cA = nA; cB = nB; ++ui;
        if constexpr (ALIGN_EPI) { if (wr == 1) PG8_BAR; }
    }
    PG8_WAIT_V(0);
    if constexpr (!ALIGN_EPI) { if (wr == 0) PG8_BAR; }
    PG8_BAR;
#undef PG8_SA
#undef PG8_SB
#undef PG8_STAGE
#undef PG8_LDA
#undef PG8_LDB
#undef PG8_MMA
#undef PG8_WAIT_V
#undef PG8_WAIT_L
#undef PG8_BAR
#undef PG8_SCHED
}
}

namespace att {
#define ATT_LAS __attribute__((address_space(3)))
typedef unsigned short bf16_t;
typedef short bf16x8 __attribute__((ext_vector_type(8)));
typedef short s16x4 __attribute__((ext_vector_type(4)));
typedef float f32x16 __attribute__((ext_vector_type(16)));
typedef unsigned u32x4 __attribute__((ext_vector_type(4)));
#define ATT_SBAR() __builtin_amdgcn_sched_barrier(0)
__device__ __forceinline__ int crow(int r, int hi) { return (r & 3) + 8 * (r >> 2) + 4 * hi; }
__device__ __forceinline__ unsigned cvtpk(float lo, float hi) { unsigned r; asm volatile("v_cvt_pk_bf16_f32 %0, %1, %2" : "=v"(r) : "v"(lo), "v"(hi)); return r; }
template <int D> __device__ __forceinline__ int kswz(int row, int chunk) { return row * (D * 2) + ((chunk * 16) ^ ((row & 7) << 4)); }
template <int NCB> __device__ __forceinline__ int v_st(int k, int c) { const int kk = (k & ~0xC) | ((k & 4) << 1) | ((k & 8) >> 1); return ((kk >> 3) * NCB + (c >> 5)) * 512 + ((kk & 7) * 32 + (c & 31)) * 2; }
__device__ __forceinline__ int v_rd_base(int lane) { return ((lane & 3) << 3) | (((lane >> 2) & 3) << 6) | (((lane >> 4) & 1) << 5) | (((lane >> 5) & 1) << 8); }

template <int DN, int DR, int DV, bool SWA>
struct Body {
    static constexpr int KN_B = 64 * DN * 2, KR_B = 64 * DR * 2, V_B = 64 * DV * 2, K_B = KN_B + KR_B, BUF_B = K_B + V_B;
    static constexpr int NCB = DV / 32, GS = NCB * 512;
    static constexpr int NQ = (DN + DR) / 16;
    static constexpr int NCH_KN = 64 * DN / 8 / 512, NCH_KR = (DR > 0) ? 1 : 0, NCH_V = 64 * DV / 8 / 512;
    static constexpr int OFF_SCR = 2 * BUF_B, OFF_BIAS = OFF_SCR + 8 * 256, LDS_TOTAL = OFF_BIAS + 384 * 4;
    static_assert(DR == 0 || DR == 64, "rope dims");

    struct Stage { bf16x8 kn[NCH_KN]; bf16x8 kr[NCH_KR ? NCH_KR : 1]; bf16x8 v[NCH_V]; };

    __device__ static __forceinline__ void stage_load(Stage& S, const bf16_t* KN, int knp, const bf16_t* KR, int krp, const bf16_t* V, int vp, int kb, int tid) {
#pragma unroll
        for (int i = 0; i < NCH_KN; ++i) { const int ci = tid + 512 * i, row = ci / (DN / 8), ch = ci % (DN / 8); S.kn[i] = *(const bf16x8*)(KN + (size_t)(kb + row) * knp + ch * 8); }
        if constexpr (DR > 0) { const int row = tid >> 3, ch = tid & 7; S.kr[0] = *(const bf16x8*)(KR + (size_t)(kb + row) * krp + ch * 8); }
#pragma unroll
        for (int i = 0; i < NCH_V; ++i) { const int ci = tid + 512 * i, row = ci / (DV / 8), ch = ci % (DV / 8); S.v[i] = *(const bf16x8*)(V + (size_t)(kb + row) * vp + ch * 8); }
    }
    __device__ static __forceinline__ void stage_write(const Stage& S, ATT_LAS char* lds, int cur, int tid) {
        ATT_LAS char* kbuf = lds + 2 * V_B + cur * K_B; ATT_LAS char* vbuf = lds + cur * V_B;
#pragma unroll
        for (int i = 0; i < NCH_KN; ++i) { const int ci = tid + 512 * i, row = ci / (DN / 8), ch = ci % (DN / 8); *(ATT_LAS bf16x8*)(kbuf + kswz<DN>(row, ch)) = S.kn[i]; }
        if constexpr (DR > 0) { const int row = tid >> 3, ch = tid & 7; *(ATT_LAS bf16x8*)(kbuf + KN_B + kswz<64>(row, ch)) = S.kr[0]; }
#pragma unroll
        for (int i = 0; i < NCH_V; ++i) { const int ci = tid + 512 * i, row = ci / (DV / 8), ch = ci % (DV / 8); *(ATT_LAS bf16x8*)(vbuf + v_st<NCB>(row, ch * 8)) = S.v[i]; }
    }
    template <int D> __device__ static __forceinline__ void qk_acc(f32x16& p0, f32x16& p1, const ATT_LAS char* Kt, int r32, int hi, const bf16x8* qr) {
        const ATT_LAS char* kb[4];
#pragma unroll
        for (int dd = 0; dd < 4; ++dd) kb[dd] = Kt + kswz<D>(r32, 2 * dd + hi);
#pragma unroll
        for (int d0 = 0; d0 < D / 16; ++d0) { const ATT_LAS char* a = kb[d0 & 3] + (d0 >> 2) * 128;
            const bf16x8 b0 = *(const ATT_LAS bf16x8*)a; const bf16x8 b1 = *(const ATT_LAS bf16x8*)(a + 32 * D * 2);
            p0 = __builtin_amdgcn_mfma_f32_32x32x16_bf16(b0, qr[d0], p0, 0, 0, 0);
            p1 = __builtin_amdgcn_mfma_f32_32x32x16_bf16(b1, qr[d0], p1, 0, 0, 0); }
    }
    template <int VOFF> __device__ static __forceinline__ void pv_tile(f32x16* o, int vaddr, bf16x8 pa0, bf16x8 pa1, bf16x8 pa2, bf16x8 pa3) {
#define ATT_TRRD(dst, off) asm volatile("ds_read_b64_tr_b16 %0, %1 offset:%2" : "=&v"(dst) : "v"(vaddr), "i"(off) : "memory")
#pragma unroll
        for (int d0 = 0; d0 < NCB; ++d0) { s16x4 l0, l1, l2, l3, h0, h1, h2, h3; const int b_ = VOFF + d0 * 512;
            ATT_TRRD(l0, b_); ATT_TRRD(h0, b_ + GS); ATT_TRRD(l1, b_ + 2 * GS); ATT_TRRD(h1, b_ + 3 * GS); ATT_TRRD(l2, b_ + 4 * GS); ATT_TRRD(h2, b_ + 5 * GS); ATT_TRRD(l3, b_ + 6 * GS); ATT_TRRD(h3, b_ + 7 * GS);
            asm volatile("s_waitcnt lgkmcnt(0)" ::: "memory"); ATT_SBAR();
            o[d0] = __builtin_amdgcn_mfma_f32_32x32x16_bf16(pa0, (bf16x8){l0[0], l0[1], l0[2], l0[3], h0[0], h0[1], h0[2], h0[3]}, o[d0], 0, 0, 0);
            o[d0] = __builtin_amdgcn_mfma_f32_32x32x16_bf16(pa1, (bf16x8){l1[0], l1[1], l1[2], l1[3], h1[0], h1[1], h1[2], h1[3]}, o[d0], 0, 0, 0);
            o[d0] = __builtin_amdgcn_mfma_f32_32x32x16_bf16(pa2, (bf16x8){l2[0], l2[1], l2[2], l2[3], h2[0], h2[1], h2[2], h2[3]}, o[d0], 0, 0, 0);
            o[d0] = __builtin_amdgcn_mfma_f32_32x32x16_bf16(pa3, (bf16x8){l3[0], l3[1], l3[2], l3[3], h3[0], h3[1], h3[2], h3[3]}, o[d0], 0, 0, 0); }
#undef ATT_TRRD
    }

    struct State { bf16x8 qr[NQ]; f32x16 o[NCB]; float m, l; };

    template <int CUR> __device__ static __forceinline__ void tile(State& st, ATT_LAS char* lds, int ldsaddr, int r32, int hi, int wid, int dq, unsigned W, bool needmask, float scl) {
        const ATT_LAS char* buf = lds + 2 * V_B + CUR * K_B;
        f32x16 p0 = {}, p1 = {};
        qk_acc<DN>(p0, p1, buf, r32, hi, st.qr);
        if constexpr (DR > 0) qk_acc<DR>(p0, p1, buf + KN_B, r32, hi, st.qr + DN / 16);
        if constexpr (SWA) {
            const ATT_LAS float* tl = (const ATT_LAS float*)(lds + OFF_BIAS) + (256 - dq);
#pragma unroll
            for (int r = 0; r < 16; ++r) { const int c = (r & 3) + 8 * (r >> 2); p0[r] = fmaf(p0[r], scl, tl[c]); p1[r] = fmaf(p1[r], scl, tl[c + 32]); }
        }
        if (needmask) { const float NEG = -__builtin_inff();
#pragma unroll
            for (int r = 0; r < 16; ++r) { const int c = (r & 3) + 8 * (r >> 2);
                if ((unsigned)(dq - c) >= W) p0[r] = NEG;
                if ((unsigned)(dq - c - 32) >= W) p1[r] = NEG; } }
        float pmax = p0[0];
#pragma unroll
        for (int r = 1; r < 16; ++r) pmax = fmaxf(pmax, p0[r]);
#pragma unroll
        for (int r = 0; r < 16; ++r) pmax = fmaxf(pmax, p1[r]);
        { auto rr = __builtin_amdgcn_permlane32_swap(__float_as_uint(pmax), __float_as_uint(pmax), false, false); pmax = fmaxf(__uint_as_float(rr[0]), __uint_as_float(rr[1])); }
        const float mn = fmaxf(st.m, pmax); const float alpha = __builtin_amdgcn_exp2f(st.m - mn); st.m = mn;
        float ps = 0.f;
#pragma unroll
        for (int r = 0; r < 16; ++r) { p0[r] = __builtin_amdgcn_exp2f(p0[r] - mn); p1[r] = __builtin_amdgcn_exp2f(p1[r] - mn); ps += p0[r] + p1[r]; }
        { auto rr = __builtin_amdgcn_permlane32_swap(__float_as_uint(ps), __float_as_uint(ps), false, false); ps = __uint_as_float(rr[0]) + __uint_as_float(rr[1]); }
        st.l = st.l * alpha + ps;
        bf16x8 pa0, pa1, pa2, pa3;
#define ATT_PK4(P, B_, OUT) do { unsigned a0 = cvtpk(P[B_ + 0], P[B_ + 1]), a1 = cvtpk(P[B_ + 2], P[B_ + 3]); unsigned b0 = cvtpk(P[B_ + 4], P[B_ + 5]), b1 = cvtpk(P[B_ + 6], P[B_ + 7]); \
        auto r0 = __builtin_amdgcn_permlane32_swap(a0, b0, false, false); auto r1 = __builtin_amdgcn_permlane32_swap(a1, b1, false, false); \
        u32x4 w = {r0[0], r1[0], r0[1], r1[1]}; OUT = *reinterpret_cast<bf16x8*>(&w); } while (0)
        ATT_PK4(p0, 0, pa0); ATT_PK4(p0, 8, pa1); ATT_PK4(p1, 0, pa2); ATT_PK4(p1, 8, pa3);
#undef ATT_PK4
        if (__any(alpha < 1.f)) { ATT_LAS float* al = (ATT_LAS float*)(lds + OFF_SCR) + wid * 64;
            if (hi == 0) al[r32] = alpha;
            asm volatile("s_waitcnt lgkmcnt(0)" ::: "memory");
#pragma unroll
            for (int r = 0; r < 16; ++r) { const float a = al[crow(r, hi)];
#pragma unroll
                for (int d0 = 0; d0 < NCB; ++d0) st.o[d0][r] *= a; }
            asm volatile("s_waitcnt lgkmcnt(0)" ::: "memory"); }
        ATT_SBAR();
        pv_tile<CUR * V_B>(st.o, ldsaddr, pa0, pa1, pa2, pa3);
    }

    __device__ static __forceinline__ void unit(ATT_LAS char* lds, const bf16_t* Qrow, int qpitch, const bf16_t* KN, int knp, const bf16_t* KR, int krp, const bf16_t* V, int vp,
                                                bf16_t* Orow, int opitch, int r0, int kb0, int NT, unsigned W, float scl, float sinkl2) {
        const int tid = threadIdx.x, lane = tid & 63, r32 = lane & 31, hi = lane >> 5; const int wid = __builtin_amdgcn_readfirstlane(tid >> 6);
        const int ldsaddr = (int)(unsigned)(uintptr_t)lds + v_rd_base(lane);
        State st;
#pragma unroll
        for (int d0 = 0; d0 < NQ; ++d0) st.qr[d0] = *(const bf16x8*)(Qrow + (size_t)r32 * qpitch + d0 * 16 + hi * 8);
#pragma unroll
        for (int d0 = 0; d0 < NCB; ++d0) st.o[d0] = f32x16{};
        st.m = -1e30f; st.l = 0.f;
        Stage sg;
        stage_load(sg, KN, knp, KR, krp, V, vp, kb0, tid);
        stage_write(sg, lds, 0, tid);
        __syncthreads();
        const int rowpos = r0 + r32;
#define ATT_STEP(CUR, t) do { const int kb_ = kb0 + 64 * (t); const bool more_ = (t) + 1 < NT; \
        if (more_) stage_load(sg, KN, knp, KR, krp, V, vp, kb_ + 64, tid); \
        const bool act_ = (kb_ <= r0 + 31) && ((long)kb_ + 63 >= (long)r0 - (long)(W - 1u)); \
        if (act_) { const bool nm_ = SWA || (kb_ + 63 > r0); tile<CUR>(st, lds, ldsaddr, r32, hi, wid, rowpos - kb_ - 4 * hi, W, nm_, scl); } \
        if (more_) stage_write(sg, lds, (CUR) ^ 1, tid); \
        __syncthreads(); } while (0)
        int t = 0;
        for (; t + 1 < NT; t += 2) { ATT_STEP(0, t); ATT_STEP(1, t + 1); }
        if (t < NT) { ATT_STEP(0, t); }
#undef ATT_STEP
        if constexpr (SWA) st.l += __builtin_amdgcn_exp2f(sinkl2 - st.m);
        ATT_LAS float* li = (ATT_LAS float*)(lds + OFF_SCR) + wid * 64 + 32;
        if (hi == 0) li[r32] = st.l;
        asm volatile("s_waitcnt lgkmcnt(0)" ::: "memory");
        float rli[16];
#pragma unroll
        for (int r = 0; r < 16; ++r) rli[r] = __builtin_amdgcn_rcpf(li[crow(r, hi)]);
#pragma unroll
        for (int r = 0; r < 16; ++r) { const int orow = crow(r, hi);
#pragma unroll
            for (int d0 = 0; d0 < NCB; ++d0) { const float v = st.o[d0][r] * rli[r]; const float vn = __shfl_xor(v, 1);
                if ((r32 & 1) == 0) *(unsigned*)(Orow + (size_t)orow * opitch + d0 * 32 + r32) = cvtpk(v, vn); } }
        __syncthreads();
    }
};
}

constexpr int D_MODEL = 1024, BATCH = 8, SEQ = 2048, M = BATCH * SEQ, D_FF = 2816, N_MOD = 9;
constexpr int D_IN = 1216, D_IN_PAD = 1280;
constexpr float EPS = 1e-6f;
constexpr float L2E = 1.4426950408889634f;
constexpr int NWAVES = 8;

constexpr size_t MiB = 1u << 20;
constexpr size_t WS_CTL = 0;
constexpr size_t WS_MOD = 1 * MiB;
constexpr size_t WS_ROPE = 2 * MiB;
constexpr size_t WS_W1GU = 4 * MiB;
constexpr size_t WS_W1D = 15 * MiB;
constexpr size_t WS_W2GU = 21 * MiB;
constexpr size_t WS_W2D = 32 * MiB;
constexpr size_t WS_WIN = 38 * MiB;
constexpr size_t WS_WO = 41 * MiB;
constexpr size_t WS_WUQ = 43 * MiB;
constexpr size_t WS_WUKV = 44 * MiB;
constexpr size_t WS_H = 46 * MiB;
constexpr size_t WS_ACT = 78 * MiB;
constexpr size_t WS_PROJ = 78 * MiB;
constexpr size_t WS_Q = 118 * MiB;
constexpr size_t WS_KV = 142 * MiB;
constexpr size_t WS_MIX = 174 * MiB;
constexpr size_t WS_QN = 206 * MiB;
constexpr size_t WS_KVN = 214 * MiB;
constexpr size_t WS_KR = 218 * MiB;
constexpr size_t WS_STATX = 220 * MiB;
constexpr size_t WS_STATQ = 221 * MiB;
constexpr size_t WS_STATKV = 221 * MiB + 512 * 1024;
constexpr size_t WS_BIAS2 = 222 * MiB;
constexpr size_t WS_BIAS3 = 222 * MiB + 256 * 1024;
constexpr size_t WS_END = 224 * MiB;

constexpr int LDS_BYTES = 147456;

typedef unsigned short bf16;
typedef float f32x4 __attribute__((ext_vector_type(4)));
typedef unsigned v4u __attribute__((ext_vector_type(4)));
typedef short bf16x8 __attribute__((ext_vector_type(8)));
#define LAS __attribute__((address_space(3)))

__device__ __forceinline__ unsigned f2bf(float f) { unsigned u = __builtin_bit_cast(unsigned, f); return (u + 0x7fffu + ((u >> 16) & 1u)) >> 16; }
__device__ __forceinline__ unsigned pk2(float lo, float hi) { return f2bf(lo) | (f2bf(hi) << 16); }
__device__ __forceinline__ float bf2f(unsigned short h) { return __builtin_bit_cast(float, (unsigned)h << 16); }
__device__ __forceinline__ float wave_sum(float v) {
#pragma unroll
    for (int o = 1; o < 64; o <<= 1) v += __shfl_xor(v, o);
    return v;
}

typedef __attribute__((address_space(1))) unsigned gu32;
#define RLX_AGENT __ATOMIC_RELAXED, __HIP_MEMORY_SCOPE_AGENT
#define XB_TMO      128
#define XB_XCNT(j)  (256  + 64 * (j))
#define XB_XSUB(j)  (1280 + 64 * (j))
#define XB_XGEN(j)  (2304 + 64 * (j))
#define XB_TOP      3328
#define XB_TOPGEN   3392
#define XCD_BAR_WORDS 3456
#define XB_SPIN_CAP (1u << 18)

__device__ __forceinline__ unsigned xb_ld(unsigned* p)              { return __hip_atomic_load(p, __ATOMIC_RELAXED, __HIP_MEMORY_SCOPE_AGENT); }
__device__ __forceinline__ unsigned xb_add(unsigned* p, unsigned v) { return __hip_atomic_fetch_add(p, v, __ATOMIC_RELAXED, __HIP_MEMORY_SCOPE_AGENT); }
__device__ __forceinline__ unsigned xb_xcc_id() { return (unsigned)__builtin_amdgcn_s_getreg((3 << 11) | 20) & 0xFu; }
#define XB_SPIN(cond, bar) do { unsigned _sp = 0; while (cond) { __builtin_amdgcn_s_sleep(1); \
    if ((++_sp & 255u) == 0u) { if (xb_ld(&(bar)[XB_TMO])) break; if (_sp > XB_SPIN_CAP) { atomicAdd(&(bar)[XB_TMO], 1u); break; } } } } while (0)

struct XcdBarrier {
    unsigned* bar; unsigned x;
    volatile LAS unsigned* st;
};

__device__ __forceinline__ XcdBarrier xcd_barrier_post(unsigned* bar, volatile LAS unsigned* st) {
    XcdBarrier b; b.bar = bar; b.x = xb_xcc_id(); b.st = st;
    if (threadIdx.x == 0) (void)xb_add(&bar[XB_XCNT(b.x)], 1u);
    return b;
}
__device__ __forceinline__ void xcd_barrier_complete(unsigned* bar, unsigned x, unsigned& nloc, unsigned& nx) {
    const unsigned G = gridDim.x * gridDim.y * gridDim.z;
    unsigned sum, cnt, mine, sp = 0u;
    for (;;) {
        sum = 0u; cnt = 0u; mine = 0u;
#pragma unroll
        for (unsigned j = 0; j < 16; ++j) { const unsigned c = xb_ld(&bar[XB_XCNT(j)]); sum += c; cnt += (c > 0u) ? 1u : 0u; mine = (j == x) ? c : mine; }
        if (sum == G) break;
        __builtin_amdgcn_s_sleep(1);
        if ((++sp & 255u) == 0u) { if (xb_ld(&bar[XB_TMO])) break; if (sp > XB_SPIN_CAP) { atomicAdd(&bar[XB_TMO], 1u); break; } }
    }
    nloc = mine > 0u ? mine : 1u; nx = cnt > 0u ? cnt : 1u;
}

__device__ __forceinline__ void xcd_barrier(const XcdBarrier& b) {
    asm volatile("s_waitcnt vmcnt(0)" ::: "memory");
    __syncthreads();
    if (threadIdx.x == 0) {
        unsigned* bar = b.bar;
        __builtin_amdgcn_s_waitcnt(0);
        unsigned nloc = b.st[0], nx = b.st[1];
        if (nloc == 0u) { xcd_barrier_complete(bar, b.x, nloc, nx); b.st[0] = nloc; b.st[1] = nx; }
        const unsigned old = xb_add(&bar[XB_XSUB(b.x)], 1u);
        const unsigned gen = old / nloc;
        if (old + 1u == (gen + 1u) * nloc) {
            __builtin_amdgcn_fence(__ATOMIC_RELEASE, "agent");
            asm volatile("s_waitcnt vmcnt(0)" ::: "memory");
            const unsigned og = xb_add(&bar[XB_TOP], 1u);
            const unsigned tg = og / nx;
            if (og + 1u == (tg + 1u) * nx) xb_add(&bar[XB_TOPGEN], 1u);
            else XB_SPIN(xb_ld(&bar[XB_TOPGEN]) == tg, bar);
            __builtin_amdgcn_fence(__ATOMIC_ACQUIRE, "agent");
            xb_add(&bar[XB_XGEN(b.x)], 1u);
            asm volatile("s_waitcnt vmcnt(0)" ::: "memory");
        } else {
            XB_SPIN(xb_ld(&bar[XB_XGEN(b.x)]) == gen, bar);
            __builtin_amdgcn_fence(__ATOMIC_ACQUIRE, "agent");
            asm volatile("s_waitcnt vmcnt(0)" ::: "memory");
        }
    }
    __syncthreads();
}

struct Args {
    const float* in[22]; float* out; unsigned char* ws; int ph_lo, ph_hi;
};

template <class RowMap>
__device__ __forceinline__ void transpose_item(const float* W, int K, int N, bf16* WT, LAS float* scr, int item, int lane, RowMap rm, const float* kgain = nullptr) {
    const int nblk = N / 32, kb = item / nblk, nb = item % nblk, k0 = 64 * kb, n0 = 32 * nb;
#pragma unroll 8
    for (int i = 0; i < 32; ++i) { const int kk = 2 * i + (lane >> 5); float wv = W[(size_t)(k0 + kk) * N + n0 + (lane & 31)]; if (kgain) wv *= kgain[k0 + kk]; scr[kk * 33 + (lane & 31)] = wv; }
    asm volatile("s_waitcnt lgkmcnt(0)" ::: "memory");
    const int c = lane & 7;
#pragma unroll
    for (int j = 0; j < 4; ++j) { const int n = (lane >> 3) + 8 * j; const LAS float* s = scr + (8 * c) * 33 + n;
        v4u o; o.x = pk2(s[0 * 33], s[1 * 33]); o.y = pk2(s[2 * 33], s[3 * 33]); o.z = pk2(s[4 * 33], s[5 * 33]); o.w = pk2(s[6 * 33], s[7 * 33]);
        *(v4u*)(WT + (size_t)rm(n0 + n) * K + k0 + 8 * c) = o; }
    asm volatile("s_waitcnt lgkmcnt(0)" ::: "memory");
}
struct RmId { __device__ __forceinline__ int operator()(int n) const { return n; } };
struct RmGU { int sel; __device__ __forceinline__ int operator()(int n) const { return (n >> 7) * 256 + sel * 128 + (n & 127); } };
struct RmIn { __device__ __forceinline__ int operator()(int n) const { if (n < 1152) return n; int i = n - 1152; if (i < 32) return 1152 + 8 * (i >> 2) + (i & 3); i -= 32; return 1152 + 8 * (i >> 2) + 4 + (i & 3); } };
struct RmUq { __device__ __forceinline__ int operator()(int n) const { const int h = n / 192, off = n % 192; if (off < 128) return n; int i = off - 128; int pos;
        if (i < 32) pos = 8 * (i >> 2) + (i & 3); else { i -= 32; pos = 8 * (i >> 2) + 4 + (i & 3); } return 192 * h + 128 + pos; } };

__device__ __forceinline__ int t5_bucket(int dist) {
    if (dist < 16) return dist;
    const float v = __logf((float)dist * (1.0f / 16.0f)) * (16.0f / 2.0794415416798357f);
    int b = 16 + (int)v; return b > 31 ? 31 : b;
}

__device__ __forceinline__ unsigned char* ld_ptr(LAS unsigned long long* ptab, int i) {
    const unsigned long long v = ptab[i];
    const unsigned lo = __builtin_amdgcn_readfirstlane((unsigned)v), hi = __builtin_amdgcn_readfirstlane((unsigned)(v >> 32));
    return (unsigned char*)(__attribute__((address_space(1))) unsigned char*)(uintptr_t)(((unsigned long long)hi << 32) | lo);
}
__device__ __forceinline__ void modnorm(const float* src, const float* gain, const float* MOD, int chunk, bf16* H, int gw, int NGW, int lane) {
    for (int r8 = gw; r8 < M / 8; r8 += NGW) {
        const int row0 = r8 * 8, b = row0 / SEQ;
        const float* shp = MOD + (size_t)b * (N_MOD * D_MODEL) + (size_t)chunk * D_MODEL; const float* scp = shp + D_MODEL;
        f32x4 gg[4], sh[4];
#pragma unroll
        for (int j = 0; j < 4; ++j) { const f32x4 g = ((const f32x4*)gain)[lane + 64 * j], sc = ((const f32x4*)scp)[lane + 64 * j]; gg[j] = g * (1.0f + sc); sh[j] = ((const f32x4*)shp)[lane + 64 * j]; }
        for (int rr = 0; rr < 8; ++rr) { const int row = row0 + rr;
            const f32x4* xr = (const f32x4*)(src + (size_t)row * D_MODEL) + lane;
            f32x4 v[4]; float s = 0.f;
#pragma unroll
            for (int j = 0; j < 4; ++j) { v[j] = xr[64 * j]; s += (v[j].x * v[j].x + v[j].y * v[j].y) + (v[j].z * v[j].z + v[j].w * v[j].w); }
            const float rstd = 1.0f / sqrtf(wave_sum(s) * (1.0f / D_MODEL) + EPS);
            unsigned long long* o8 = (unsigned long long*)(H + (size_t)row * D_MODEL) + lane;
#pragma unroll
            for (int j = 0; j < 4; ++j) { const f32x4 y = v[j] * rstd * gg[j] + sh[j];
                o8[64 * j] = (unsigned long long)pk2(y.x, y.y) | ((unsigned long long)pk2(y.z, y.w) << 32); } }
    }
}
__device__ __forceinline__ void biasgemv(const bf16* WT, int N, const float* MOD, int chunk, float* BIAS, int gw, int NGW, int lane) {
    float shv[8][16];
#pragma unroll
    for (int b = 0; b < 8; ++b)
#pragma unroll
        for (int c = 0; c < 2; ++c) { const float* sp = MOD + (size_t)b * (N_MOD * D_MODEL) + (size_t)chunk * D_MODEL + c * 512 + 8 * lane; const f32x4 a = *(const f32x4*)sp, d = *(const f32x4*)(sp + 4);
            shv[b][c * 8 + 0] = a[0]; shv[b][c * 8 + 1] = a[1]; shv[b][c * 8 + 2] = a[2]; shv[b][c * 8 + 3] = a[3]; shv[b][c * 8 + 4] = d[0]; shv[b][c * 8 + 5] = d[1]; shv[b][c * 8 + 6] = d[2]; shv[b][c * 8 + 7] = d[3]; }
    for (int n = gw; n < N; n += NGW) { const bf16* wr_ = WT + (size_t)n * D_MODEL + 8 * lane; const bf16x8 w0 = *(const bf16x8*)wr_, w1 = *(const bf16x8*)(wr_ + 512); float wf[16];
#pragma unroll
        for (int j = 0; j < 8; ++j) { wf[j] = bf2f((unsigned short)w0[j]); wf[8 + j] = bf2f((unsigned short)w1[j]); }
#pragma unroll
        for (int b = 0; b < 8; ++b) { float sacc = 0.f;
#pragma unroll
            for (int j = 0; j < 16; ++j) sacc = fmaf(wf[j], shv[b][j], sacc);
            sacc = wave_sum(sacc); if (lane == 0) BIAS[(size_t)b * N + n] = sacc; } }
}

__global__ void __launch_bounds__(NWAVES * 64, 2) fwd_kernel(Args args) {
    extern __shared__ __attribute__((aligned(16))) unsigned char lds_raw[];
    LAS unsigned char* lds = (LAS unsigned char*)lds_raw;
    const int tid = threadIdx.x, lane = tid & 63, wave = __builtin_amdgcn_readfirstlane(tid >> 6);
    const int G = gridDim.x, bx = blockIdx.x;
    const int vcu = (G % 8 == 0) ? (bx % 8) * (G / 8) + bx / 8 : bx;
    const int gw = vcu * NWAVES + wave, NGW = G * NWAVES;
    volatile LAS unsigned* MISC = (volatile LAS unsigned*)(lds + 131072 + 320);
    LAS unsigned long long* ptab = (LAS unsigned long long*)(lds + 131072 + 1024);
    for (int u = tid; u < (LDS_BYTES - 131072) / 4; u += NWAVES * 64) ((LAS unsigned*)(lds + 131072))[u] = 0u;
    __syncthreads();
    if (tid < 22) ptab[tid] = (unsigned long long)(uintptr_t)args.in[tid];
    if (tid == 22) ptab[22] = (unsigned long long)(uintptr_t)args.out;
    if (tid == 23) ptab[23] = (unsigned long long)(uintptr_t)args.ws;
    __syncthreads();
    XcdBarrier bar = xcd_barrier_post((unsigned*)(args.ws + WS_CTL) + 4096, MISC + 8);
#define LDP(i) ((const float*)ld_ptr(ptab, (i)))
#define WSP(T, off) ((T*)(ld_ptr(ptab, 23) + (off)))
#define XOUT ((float*)ld_ptr(ptab, 22))
#define RSL ((LAS float*)(lds + 131072 + 2048))
    const int lo = args.ph_lo, hi = args.ph_hi;
#ifndef PH_MASK
#define PH_MASK 0xFFFFFFFFu
#endif
#define IN(k) (((PH_MASK >> (k)) & 1u) && lo <= (k) && (k) < hi)
#ifndef PROBE_DBL
#define PROBE_DBL 0u
#endif
#ifndef PROBE_SYNCS
#define PROBE_SYNCS 0
#endif
#define PHASE(k) for (int rep_ = 0; rep_ < (IN(k) ? 1 + (int)((PROBE_DBL >> (k)) & 1u) : 0); ++rep_)
#define SEAM(k) do { if (IN(k) && IN((k) + 1)) xcd_barrier(bar); } while (0)

    PHASE(0) { const float* c_in = LDP(1); const float* w_mod = LDP(2); const float* b_mod = LDP(3); float* MOD = WSP(float, WS_MOD); float* ROPE = WSP(float, WS_ROPE); bf16* W1GU = WSP(bf16, WS_W1GU); bf16* W1D = WSP(bf16, WS_W1D); bf16* W2GU = WSP(bf16, WS_W2GU); bf16* W2D = WSP(bf16, WS_W2D); bf16* WIN = WSP(bf16, WS_WIN); bf16* WO = WSP(bf16, WS_WO); bf16* WUQ = WSP(bf16, WS_WUQ); bf16* WUKV = WSP(bf16, WS_WUKV);
        for (int u = bx; u < (N_MOD * D_MODEL) / 64; u += G) {
            LAS float* sact = (LAS float*)lds;
            LAS float* part = (LAS float*)(lds + 32768);
            for (int i = tid; i < BATCH * D_MODEL; i += NWAVES * 64) { const float v = c_in[i]; sact[i] = v / (1.0f + __expf(-v)); }
            __syncthreads();
            const int n = 64 * u + lane; float acc[8];
#pragma unroll
            for (int b = 0; b < 8; ++b) acc[b] = 0.f;
            const float* wp = w_mod + (size_t)(128 * wave) * (N_MOD * D_MODEL) + n;
#pragma unroll 8
            for (int k = 0; k < 128; ++k) { const float wv = wp[(size_t)k * (N_MOD * D_MODEL)];
#pragma unroll
                for (int b = 0; b < 8; ++b) acc[b] = fmaf(sact[b * 1024 + 128 * wave + k], wv, acc[b]); }
#pragma unroll
            for (int b = 0; b < 8; ++b) part[(wave * 8 + b) * 64 + lane] = acc[b];
            __syncthreads();
            { const int b = tid >> 6; float s = 0.f;
#pragma unroll
              for (int w = 0; w < 8; ++w) s += part[(w * 8 + b) * 64 + lane];
              MOD[(size_t)b * (N_MOD * D_MODEL) + n] = s + b_mod[n]; }
            __syncthreads();
        }
        for (int idx = bx * (NWAVES * 64) + tid; idx < SEQ * 32; idx += G * NWAVES * 64) { const int p = idx >> 5, i = idx & 31;
            const float inv = powf(10000.0f, -(float)(2 * i) / 64.0f); const float ang = (float)p * inv;
            ROPE[2 * idx] = cosf(ang); ROPE[2 * idx + 1] = sinf(ang); }
        LAS float* scr = (LAS float*)(lds + wave * 16384);
        constexpr int I_GU = (D_MODEL / 64) * (D_FF / 32), I_D = (D_FF / 64) * (D_MODEL / 32), I_IN = (D_MODEL / 64) * (D_IN / 32), I_O = (D_MODEL / 64) * (D_MODEL / 32),
                      I_UQ = (256 / 64) * (768 / 32), I_UKV = (128 / 64) * (1024 / 32);
        constexpr int NITEMS = 4 * I_GU + 2 * I_D + I_IN + I_O + I_UQ + I_UKV;
        for (int it = gw; it < NITEMS; it += NGW) {
            int r = it;
            if (r < I_GU) { transpose_item(LDP(5), D_MODEL, D_FF, W1GU, scr, r, lane, RmGU{0}); continue; } r -= I_GU;
            if (r < I_GU) { transpose_item(LDP(6), D_MODEL, D_FF, W1GU, scr, r, lane, RmGU{1}); continue; } r -= I_GU;
            if (r < I_GU) { transpose_item(LDP(17), D_MODEL, D_FF, W2GU, scr, r, lane, RmGU{0}); continue; } r -= I_GU;
            if (r < I_GU) { transpose_item(LDP(18), D_MODEL, D_FF, W2GU, scr, r, lane, RmGU{1}); continue; } r -= I_GU;
            if (r < I_D) { transpose_item(LDP(7), D_FF, D_MODEL, W1D, scr, r, lane, RmId{}); continue; } r -= I_D;
            if (r < I_D) { transpose_item(LDP(19), D_FF, D_MODEL, W2D, scr, r, lane, RmId{}); continue; } r -= I_D;
            if (r < I_IN) { transpose_item(LDP(9), D_MODEL, D_IN, WIN, scr, r, lane, RmIn{}); continue; } r -= I_IN;
            if (r < I_O) { transpose_item(LDP(15), D_MODEL, D_MODEL, WO, scr, r, lane, RmId{}); continue; } r -= I_O;
            if (r < I_UQ) { transpose_item(LDP(12), 256, 768, WUQ, scr, r, lane, RmUq{}, LDP(10)); continue; } r -= I_UQ;
            transpose_item(LDP(13), 128, 1024, WUKV, scr, r, lane, RmId{}, LDP(11));
        }
        for (int i = bx * (NWAVES * 64) + tid; i < (D_IN_PAD - D_IN) * D_MODEL / 8; i += G * NWAVES * 64) ((v4u*)(WIN + (size_t)D_IN * D_MODEL))[i] = (v4u){0u, 0u, 0u, 0u};
    }
    SEAM(0);
    for (int es_ = 0; es_ < PROBE_SYNCS; ++es_) xcd_barrier(bar);

    PHASE(1) { const float* x_in = LDP(0); const float* norm_ffn1 = LDP(4); float* MOD = WSP(float, WS_MOD); bf16* H = WSP(bf16, WS_H); bf16* WIN = WSP(bf16, WS_WIN); bf16* W2GU = WSP(bf16, WS_W2GU); float* BIAS2 = WSP(float, WS_BIAS2); float* BIAS3 = WSP(float, WS_BIAS3);
        modnorm(x_in, norm_ffn1, MOD, 0, H, gw, NGW, lane); biasgemv(WIN, D_IN_PAD, MOD, 3, BIAS2, gw, NGW, lane); biasgemv(W2GU, 2 * D_FF, MOD, 6, BIAS3, gw, NGW, lane); }
    SEAM(1);
    PHASE(2) { bf16* H = WSP(bf16, WS_H); bf16* W1GU = WSP(bf16, WS_W1GU); bf16* ACT = WSP(bf16, WS_ACT); pg8::Gemm g{H, W1GU, M, 2 * D_FF, D_MODEL, D_MODEL}; pg8::StaticOrder S; S.init(M, 2 * D_FF, G, bx); pg8::EpiSwiglu<false> E{ACT, nullptr, nullptr, RSL, D_FF};
        pg8::gemm_phase<pg8::EpiSwiglu<false>, pg8::StaticOrder, true, true>(lds, g, S, E); }
    SEAM(2);
    PHASE(3) { bf16* ACT = WSP(bf16, WS_ACT); bf16* W1D = WSP(bf16, WS_W1D); const float* x_in = LDP(0); float* X = XOUT; float* MOD = WSP(float, WS_MOD); const float* norm_mix = LDP(8); bf16* H = WSP(bf16, WS_H); float* STATX = WSP(float, WS_STATX); pg8::Gemm g{ACT, W1D, M, D_MODEL, D_FF, D_FF}; pg8::StaticOrder S; S.init(M, D_MODEL, G, bx);
        pg8::EpiResid<true> E{x_in, X, MOD + 2 * D_MODEL, norm_mix, MOD + 4 * D_MODEL, H, STATX, 0.5f};
        pg8::gemm_phase<pg8::EpiResid<true>, pg8::StaticOrder, true, true>(lds, g, S, E); }
    SEAM(3);
    PHASE(4) { bf16* H = WSP(bf16, WS_H); bf16* WIN = WSP(bf16, WS_WIN); bf16* PROJ = WSP(bf16, WS_PROJ); float* STATX = WSP(float, WS_STATX); float* BIAS2 = WSP(float, WS_BIAS2); float* STATQ = WSP(float, WS_STATQ); float* STATKV = WSP(float, WS_STATKV); bf16* KR = WSP(bf16, WS_KR); float* ROPE = WSP(float, WS_ROPE); pg8::Gemm g{H, WIN, M, D_IN_PAD, D_MODEL, D_MODEL}; pg8::StaticOrder S; S.init(M, D_IN_PAD, G, bx); pg8::EpiProj E{PROJ, STATX, BIAS2, STATQ, STATKV, KR, ROPE, RSL};
        pg8::gemm_phase<pg8::EpiProj, pg8::StaticOrder, true, true>(lds, g, S, E); }
    SEAM(4);
    PHASE(5) { bf16* PROJ = WSP(bf16, WS_PROJ); bf16* WUQ = WSP(bf16, WS_WUQ); bf16* Qb = WSP(bf16, WS_Q); float* ROPE = WSP(float, WS_ROPE); float* STATQ = WSP(float, WS_STATQ); bf16* WUKV = WSP(bf16, WS_WUKV); bf16* KV = WSP(bf16, WS_KV); float* STATKV = WSP(float, WS_STATKV);
        { pg8::Gemm g{PROJ + 768, WUQ, M, 768, 256, D_IN_PAD}; pg8::StaticOrder S; S.init(M, 768, G, bx); pg8::EpiQRope E{Qb, ROPE, STATQ, RSL, 768, 0.07216878364870322f * L2E};
          pg8::gemm_phase<pg8::EpiQRope, pg8::StaticOrder, true, true>(lds, g, S, E); }
        { pg8::Gemm g{PROJ + 1024, WUKV, M, 1024, 128, D_IN_PAD}; pg8::StaticOrder S; S.init(M, 1024, G, bx); pg8::EpiBf16<true> E{KV, STATKV, RSL, 1024, 1.0f / 128.0f};
          pg8::gemm_phase<pg8::EpiBf16<true>, pg8::StaticOrder, true, true>(lds, g, S, E); }
    }
    SEAM(5);
    PHASE(6) { bf16* Qb = WSP(bf16, WS_Q); bf16* KV = WSP(bf16, WS_KV); bf16* KR = WSP(bf16, WS_KR); bf16* MIX = WSP(bf16, WS_MIX); bf16* PROJ = WSP(bf16, WS_PROJ); const float* rel_bias = LDP(20); const float* sinks = LDP(14);
        LAS char* alds = (LAS char*)lds;
        {
            typedef att::Body<128, 64, 128, false> B;
            static_assert(B::LDS_TOTAL <= LDS_BYTES, "MLA LDS");
            for (int u = vcu; u < BATCH * 4 * 8; u += G) { const int bh = u >> 3, y = 7 - (u & 7), b = bh >> 2, h = bh & 3;
                const int r0 = (wave < 4) ? (128 * y + 32 * wave) : (128 * (15 - y) + 32 * (wave - 4));
                const size_t rb = (size_t)b * SEQ;
                B::unit(alds, Qb + (rb + r0) * 768 + 192 * h, 768, KV + rb * 1024 + 256 * h, 1024, KR + rb * 64, 64, KV + rb * 1024 + 256 * h + 128, 1024,
                        MIX + (rb + r0) * 1024 + 512 + 128 * h, 1024, r0, 0, 32 - 2 * y, 0x7fffffffu, 1.0f, 0.f); }
        }
        {
            typedef att::Body<64, 0, 64, true> B;
            static_assert(B::LDS_TOTAL <= LDS_BYTES, "SWA LDS");
            for (int u = vcu; u < BATCH * 8 * 8; u += G) { const int bh = u >> 3, qb = u & 7, b = bh >> 3, h = bh & 7, gkv = h >> 2;
                LAS float* tb = (LAS float*)(alds + B::OFF_BIAS);
                if (tid < 384) { const int dist = 256 - tid; tb[tid] = (dist >= 0 && dist < 128) ? rel_bias[t5_bucket(dist) * 8 + h] * L2E : 0.f; }
                const int r0 = 256 * qb + 32 * wave; const int kb0 = qb == 0 ? 0 : 256 * qb - 128; const int NT = (256 * qb + 256 - kb0) / 64;
                const size_t rb = (size_t)b * SEQ;
                B::unit(alds, PROJ + (rb + r0) * D_IN_PAD + 64 * h, D_IN_PAD, PROJ + rb * D_IN_PAD + 512 + 64 * gkv, D_IN_PAD, nullptr, 0, PROJ + rb * D_IN_PAD + 640 + 64 * gkv, D_IN_PAD,
                        MIX + (rb + r0) * 1024 + 64 * h, 1024, r0, kb0, NT, 128u, 0.125f * L2E, sinks[h] * L2E); }
        }
    }
    SEAM(6);
    PHASE(7) { bf16* MIX = WSP(bf16, WS_MIX); bf16* WO = WSP(bf16, WS_WO); float* X = XOUT; float* MOD = WSP(float, WS_MOD); const float* norm_ffn2 = LDP(16); bf16* H = WSP(bf16, WS_H); float* STATX = WSP(float, WS_STATX); pg8::Gemm g{MIX, WO, M, D_MODEL, D_MODEL, D_MODEL}; pg8::StaticOrder S; S.init(M, D_MODEL, G, bx);
        pg8::EpiResid<true> E{X, X, MOD + 5 * D_MODEL, norm_ffn2, MOD + 7 * D_MODEL, H, STATX, 1.0f};
        pg8::gemm_phase<pg8::EpiResid<true>, pg8::StaticOrder, true, true>(lds, g, S, E); }
    SEAM(7);
    PHASE(8) { bf16* H = WSP(bf16, WS_H); bf16* W2GU = WSP(bf16, WS_W2GU); bf16* ACT = WSP(bf16, WS_ACT); float* STATX = WSP(float, WS_STATX); float* BIAS3 = WSP(float, WS_BIAS3); pg8::Gemm g{H, W2GU, M, 2 * D_FF, D_MODEL, D_MODEL}; pg8::StaticOrder S; S.init(M, 2 * D_FF, G, bx); pg8::EpiSwiglu<true> E{ACT, STATX, BIAS3, RSL, D_FF};
        pg8::gemm_phase<pg8::EpiSwiglu<true>, pg8::StaticOrder, true, true>(lds, g, S, E); }
    SEAM(8);
    PHASE(9) { bf16* ACT = WSP(bf16, WS_ACT); bf16* W2D = WSP(bf16, WS_W2D); float* X = XOUT; float* MOD = WSP(float, WS_MOD); pg8::Gemm g{ACT, W2D, M, D_MODEL, D_FF, D_FF}; pg8::StaticOrder S; S.init(M, D_MODEL, G, bx);
        pg8::EpiResid<false> E{X, X, MOD + 8 * D_MODEL, nullptr, nullptr, nullptr, nullptr, 0.5f};
        pg8::gemm_phase<pg8::EpiResid<false>, pg8::StaticOrder, true, true>(lds, g, S, E); }
    SEAM(9);
    PHASE(10) { const float* norm_final = LDP(21); float* X = XOUT;
        f32x4 gg[4];
#pragma unroll
        for (int j = 0; j < 4; ++j) gg[j] = ((const f32x4*)norm_final)[lane + 64 * j];
        for (int row = gw; row < M; row += NGW) { f32x4* xr = (f32x4*)(X + (size_t)row * D_MODEL) + lane; f32x4 v[4]; float s = 0.f;
#pragma unroll
            for (int j = 0; j < 4; ++j) { v[j] = xr[64 * j]; s += (v[j].x * v[j].x + v[j].y * v[j].y) + (v[j].z * v[j].z + v[j].w * v[j].w); }
            const float rstd = 1.0f / sqrtf(wave_sum(s) * (1.0f / D_MODEL) + EPS);
#pragma unroll
            for (int j = 0; j < 4; ++j) xr[64 * j] = v[j] * rstd * gg[j]; }
    }
#undef IN
#undef SEAM
#undef PHASE
#undef LDP
#undef WSP
#undef XOUT
#undef RSL
}

constexpr int N_PHASES = 11;

extern "C" void kernel_launch(void* const* d_in, const int* in_sizes, int n_in, void* d_out, int out_size, void* d_ws, size_t ws_size, hipStream_t stream) {
    static int grid = 0;
    if (grid == 0) {
        if (n_in != 22 || out_size != M * D_MODEL || ws_size < WS_END) { fprintf(stderr, "kernel_launch: unexpected shapes (n_in %d out %d ws %zu)\n", n_in, out_size, ws_size); grid = -1; return; }
        int dev = 0, cus = 0, per_cu = 0;
        hipGetDevice(&dev); hipDeviceGetAttribute(&cus, hipDeviceAttributeMultiprocessorCount, dev);
        if (hipFuncSetAttribute((const void*)fwd_kernel, hipFuncAttributeMaxDynamicSharedMemorySize, LDS_BYTES) != hipSuccess) { fprintf(stderr, "kernel_launch: hipFuncSetAttribute failed\n"); grid = -1; return; }
        if (hipOccupancyMaxActiveBlocksPerMultiprocessor(&per_cu, (const void*)fwd_kernel, NWAVES * 64, LDS_BYTES) != hipSuccess || per_cu < 1) { fprintf(stderr, "kernel_launch: occupancy query says %d\n", per_cu); grid = -1; return; }
        grid = cus;
    }
    if (grid < 0) return;
    if (hipMemsetAsync((char*)d_ws + WS_CTL, 0, 65536, stream) != hipSuccess) { fprintf(stderr, "kernel_launch: memset failed\n"); return; }
    Args a{};
    for (int i = 0; i < 22; ++i) a.in[i] = (const float*)d_in[i];
    a.out = (float*)d_out; a.ws = (unsigned char*)d_ws; a.ph_lo = 0; a.ph_hi = N_PHASES;
    void* kargs[] = {&a};
    hipError_t e = hipLaunchCooperativeKernel((const void*)fwd_kernel, dim3(grid), dim3(NWAVES * 64), kargs, LDS_BYTES, stream);
    if (e != hipSuccess) fprintf(stderr, "cooperative launch failed: %s (grid %d)\n", hipGetErrorString(e), grid);
}
```

```cpp
#include <hip/hip_runtime.h>
#include <cstdio>
#include <cstdint>

namespace pg8 {
#define PG8_LAS __attribute__((address_space(3)))
typedef unsigned short bf16_t;
typedef short bf16x8 __attribute__((ext_vector_type(8)));
typedef float f32x4 __attribute__((ext_vector_type(4)));
typedef unsigned u32x4 __attribute__((ext_vector_type(4)));
constexpr int BM = 256, BK = 64, HALF = 128, HTB = HALF * BK * 2  , STAGE_BYTES = 8 * HTB, NXCD = 8, WGM = 8;

__host__ __device__ __forceinline__ int lds_byte(int r, int c) { const int st = (r >> 4) * 2 + (c >> 5), rr = r & 15, cc = c & 31, ob = rr * 64 + cc * 2; return st * 1024 + (ob ^ (((ob >> 9) & 1) << 5)); }
__host__ __device__ __forceinline__ void stage_rc(int b, int& R, int& C) { const int st = b / 1024, sb = b % 1024, swz = sb ^ (((sb >> 9) & 1) << 5); R = (st >> 1) * 16 + swz / 64; C = (st & 1) * 32 + (swz % 64) / 2; }
__host__ __device__ __forceinline__ int perm32(int rho) { const int n = rho >> 4, i = rho & 15; return 8 * (i >> 2) + 4 * n + (i & 3); }

struct Unit { int pm, pn; };
struct Gemm { const bf16_t* A; const bf16_t* Bt; int M, N, K, lda; };

struct StaticOrder {
    int nM, nN, nwg, G, c;
    __host__ __device__ void init(int M, int N, int G_, int c_) { nM = M / BM; nN = N / BM; nwg = nM * nN; G = G_; c = c_; }
    __host__ __device__ bool next(int i, Unit& u) const {
        const long L = (long)i * G + c; if (L >= nwg) return false;
        int wgid = (int)L; { const int q = nwg / NXCD, r = nwg % NXCD, xcd = wgid % NXCD, off = wgid / NXCD; wgid = (xcd < r ? xcd * (q + 1) : r * (q + 1) + (xcd - r) * q) + off; }
        const int nig = WGM * nN, gid = wgid / nig, fm = gid * WGM, gsz = (nM - fm) < WGM ? (nM - fm) : WGM;
        u.pm = fm + ((wgid % nig) % gsz); u.pn = (wgid % nig) / gsz; return true;
    }
    __device__ __forceinline__ void a_ready(const Unit&) const {}
    __device__ __forceinline__ void done(const Unit&) const {}
};

__device__ __forceinline__ unsigned cvt_pk_bf16(float lo, float hi) { unsigned r; asm volatile("v_cvt_pk_bf16_f32 %0, %1, %2" : "=v"(r) : "v"(lo), "v"(hi)); return r; }

__device__ __forceinline__ float rstd16(const float* st, int row, float inv_n, float eps) {
    const f32x4* p = (const f32x4*)(st + (size_t)row * 16); const f32x4 a = p[0], b = p[1], c = p[2], d = p[3];
    const float s = ((a[0] + a[1]) + (a[2] + a[3])) + ((b[0] + b[1]) + (b[2] + b[3])) + ((c[0] + c[1]) + (c[2] + c[3])) + ((d[0] + d[1]) + (d[2] + d[3]));
    return 1.0f / sqrtf(s * inv_n + eps);
}
__device__ __forceinline__ float rstd4(const float* st, int row, float inv_n, float eps) {
    const f32x4 a = *(const f32x4*)(st + (size_t)row * 4); return 1.0f / sqrtf(((a[0] + a[1]) + (a[2] + a[3])) * inv_n + eps);
}
__device__ __forceinline__ float quad_sum(float s) { s += __shfl_xor(s, 16); s += __shfl_xor(s, 32); return s; }

typedef float f32x2e __attribute__((ext_vector_type(2)));
template <int NP> __device__ __forceinline__ void panel_rstd(const float* stat, int pm, float inv_n, PG8_LAS float* rsl) {
    const int t = threadIdx.x, r = t >> 1, h = t & 1; const float* p = stat + (size_t)(pm * BM + r) * NP + h * (NP / 2); float s;
    if constexpr (NP == 16) { const f32x4 a = *(const f32x4*)p, b = *(const f32x4*)(p + 4); s = ((a[0] + a[1]) + (a[2] + a[3])) + ((b[0] + b[1]) + (b[2] + b[3])); }
    else { const f32x2e a = *(const f32x2e*)p; s = a[0] + a[1]; }
    s += __shfl_xor(s, 1);
    if (h == 0) rsl[r] = 1.0f / sqrtf(s * inv_n + 1e-6f);
    asm volatile("s_waitcnt lgkmcnt(0)" ::: "memory"); __builtin_amdgcn_s_barrier(); asm volatile("" ::: "memory");
}
template <bool RS> struct EpiBf16 {
    static constexpr bool PERM = true, AFTER_DRAIN = false;
    bf16_t* O; const float* stat; PG8_LAS float* rsl; int ldc; float inv_n;
    __device__ __forceinline__ void operator()(const f32x4 (&acc)[2][2][4][2], const Unit& u, int wr, int wc, int fr, int fq) const {
        const int row0 = u.pm * BM + wr * 64 + fr; const int col0 = u.pn * BM + wc * 32 + 8 * fq;
        if constexpr (RS) panel_rstd<4>(stat, u.pm, inv_n, rsl);
#pragma unroll
        for (int ai = 0; ai < 2; ++ai)
#pragma unroll
            for (int m = 0; m < 4; ++m) { const int row = row0 + ai * HALF + m * 16; bf16_t* rowp = O + (size_t)row * ldc + col0;
                float rs = 1.0f; if constexpr (RS) rs = rsl[wr * 64 + fr + ai * HALF + m * 16];
#pragma unroll
                for (int bj = 0; bj < 2; ++bj) { const f32x4 v0 = acc[ai][bj][m][0] * rs, v1 = acc[ai][bj][m][1] * rs;
                    u32x4 w; w.x = cvt_pk_bf16(v0[0], v0[1]); w.y = cvt_pk_bf16(v0[2], v0[3]); w.z = cvt_pk_bf16(v1[0], v1[1]); w.w = cvt_pk_bf16(v1[2], v1[3]);
                    *(u32x4*)(rowp + bj * HALF) = w; } }
    }
};
__device__ __forceinline__ float silu_f(float x) { return x * __builtin_amdgcn_rcpf(1.0f + __expf(-x)); }
template <bool DEFER> struct EpiSwiglu {
    static constexpr bool PERM = true, AFTER_DRAIN = false;
    bf16_t* O; const float* stat; const float* bias; PG8_LAS float* rsl; int ldc;
    __device__ __forceinline__ void operator()(const f32x4 (&acc)[2][2][4][2], const Unit& u, int wr, int wc, int fr, int fq) const {
        const int row0 = u.pm * BM + wr * 64 + fr; const int col0 = u.pn * HALF + wc * 32 + 8 * fq;
        if constexpr (DEFER) panel_rstd<16>(stat, u.pm, 1.0f / 1024.0f, rsl);
        f32x4 bg0 = {0.f, 0.f, 0.f, 0.f}, bg1 = bg0, bu0 = bg0, bu1 = bg0;
        if constexpr (DEFER) { const float* bp = bias + (size_t)(u.pm >> 3) * (22 * 256) + u.pn * BM + wc * 32 + 8 * fq;
            bg0 = *(const f32x4*)bp; bg1 = *(const f32x4*)(bp + 4); bu0 = *(const f32x4*)(bp + HALF); bu1 = *(const f32x4*)(bp + HALF + 4); }
#pragma unroll
        for (int ai = 0; ai < 2; ++ai)
#pragma unroll
            for (int m = 0; m < 4; ++m) { const int row = row0 + ai * HALF + m * 16; bf16_t* rowp = O + (size_t)row * ldc + col0;
                f32x4 g0 = acc[ai][0][m][0], g1 = acc[ai][0][m][1], u0 = acc[ai][1][m][0], u1 = acc[ai][1][m][1];
                if constexpr (DEFER) { const float rs = rsl[wr * 64 + fr + ai * HALF + m * 16]; g0 = g0 * rs + bg0; g1 = g1 * rs + bg1; u0 = u0 * rs + bu0; u1 = u1 * rs + bu1; }
                float a[8];
#pragma unroll
                for (int j = 0; j < 4; ++j) { a[j] = silu_f(g0[j]) * u0[j]; a[4 + j] = silu_f(g1[j]) * u1[j]; }
                u32x4 w; w.x = cvt_pk_bf16(a[0], a[1]); w.y = cvt_pk_bf16(a[2], a[3]); w.z = cvt_pk_bf16(a[4], a[5]); w.w = cvt_pk_bf16(a[6], a[7]);
                *(u32x4*)rowp = w; }
    }
};
template <bool NEXT> struct EpiResid {
    static constexpr bool PERM = true, AFTER_DRAIN = false;
    const float* base; float* out; const float* gate;
    const float* ngain; const float* nscale; bf16_t* XG; float* stat;
    float coef;
    __device__ __forceinline__ void operator()(const f32x4 (&acc)[2][2][4][2], const Unit& u, int wr, int wc, int fr, int fq) const {
        const int row0 = u.pm * BM + wr * 64 + fr; const int col0 = u.pn * BM + wc * 32 + 8 * fq; const int b = u.pm >> 3;
        f32x4 ss[2]; ss[0] = (f32x4){0.f, 0.f, 0.f, 0.f}; ss[1] = ss[0];
#pragma unroll
        for (int bj = 0; bj < 2; ++bj) { const int cc = col0 + bj * HALF; const float* gp = gate + (size_t)b * 9216 + cc;
            const f32x4 gv0 = *(const f32x4*)gp * coef, gv1 = *(const f32x4*)(gp + 4) * coef;
            f32x4 gn0 = {0.f, 0.f, 0.f, 0.f}, gn1 = gn0;
            if constexpr (NEXT) { const float* sp = nscale + (size_t)b * 9216 + cc; gn0 = *(const f32x4*)(ngain + cc) * (*(const f32x4*)sp + 1.0f); gn1 = *(const f32x4*)(ngain + cc + 4) * (*(const f32x4*)(sp + 4) + 1.0f); }
#pragma unroll
            for (int ai = 0; ai < 2; ++ai) { f32x4 bs0[4], bs1[4];
#pragma unroll
                for (int m = 0; m < 4; ++m) { const size_t off = (size_t)(row0 + ai * HALF + m * 16) * 1024 + cc; bs0[m] = *(const f32x4*)(base + off); bs1[m] = *(const f32x4*)(base + off + 4); }
#pragma unroll
                for (int m = 0; m < 4; ++m) { const size_t off = (size_t)(row0 + ai * HALF + m * 16) * 1024 + cc;
                    const f32x4 o0 = bs0[m] + gv0 * acc[ai][bj][m][0], o1 = bs1[m] + gv1 * acc[ai][bj][m][1];
                    *(f32x4*)(out + off) = o0; *(f32x4*)(out + off + 4) = o1;
                    if constexpr (NEXT) { ss[ai][m] += ((o0[0] * o0[0] + o0[1] * o0[1]) + (o0[2] * o0[2] + o0[3] * o0[3])) + ((o1[0] * o1[0] + o1[1] * o1[1]) + (o1[2] * o1[2] + o1[3] * o1[3]));
                        const f32x4 x0 = o0 * gn0, x1 = o1 * gn1; u32x4 w; w.x = cvt_pk_bf16(x0[0], x0[1]); w.y = cvt_pk_bf16(x0[2], x0[3]); w.z = cvt_pk_bf16(x1[0], x1[1]); w.w = cvt_pk_bf16(x1[2], x1[3]);
                        *(u32x4*)(XG + off) = w; } }
                asm volatile("" ::: "memory"); } }
        if constexpr (NEXT) {
#pragma unroll
            for (int ai = 0; ai < 2; ++ai)
#pragma unroll
                for (int m = 0; m < 4; ++m) { const float t = quad_sum(ss[ai][m]); if (fq == 0) stat[(size_t)(row0 + ai * HALF + m * 16) * 16 + u.pn * 4 + wc] = t; } }
    }
};
struct EpiProj {
    static constexpr bool PERM = true, AFTER_DRAIN = false;
    bf16_t* O; const float* stat; const float* bias; float* statq; float* statkv; bf16_t* KR; const float* cs; PG8_LAS float* rsl;
    __device__ __forceinline__ void operator()(const f32x4 (&acc)[2][2][4][2], const Unit& u, int wr, int wc, int fr, int fq) const {
        const int row0 = u.pm * BM + wr * 64 + fr; const int col0 = u.pn * BM + wc * 32 + 8 * fq;
        panel_rstd<16>(stat, u.pm, 1.0f / 1024.0f, rsl);
        const float* bp = bias + (size_t)(u.pm >> 3) * 1280 + col0;
        const f32x4 b00 = *(const f32x4*)bp, b01 = *(const f32x4*)(bp + 4), b10 = *(const f32x4*)(bp + HALF), b11 = *(const f32x4*)(bp + HALF + 4);
#pragma unroll
        for (int ai = 0; ai < 2; ++ai)
#pragma unroll
            for (int m = 0; m < 4; ++m) { const int row = row0 + ai * HALF + m * 16; const float rs = rsl[wr * 64 + fr + ai * HALF + m * 16];
                const f32x4 v00 = acc[ai][0][m][0] * rs + b00, v01 = acc[ai][0][m][1] * rs + b01, v10 = acc[ai][1][m][0] * rs + b10, v11 = acc[ai][1][m][1] * rs + b11;
                bf16_t* rowp = O + (size_t)row * 1280 + col0;
                { u32x4 w; w.x = cvt_pk_bf16(v00[0], v00[1]); w.y = cvt_pk_bf16(v00[2], v00[3]); w.z = cvt_pk_bf16(v01[0], v01[1]); w.w = cvt_pk_bf16(v01[2], v01[3]); *(u32x4*)rowp = w; }
                if (u.pn < 4) { u32x4 w; w.x = cvt_pk_bf16(v10[0], v10[1]); w.y = cvt_pk_bf16(v10[2], v10[3]); w.z = cvt_pk_bf16(v11[0], v11[1]); w.w = cvt_pk_bf16(v11[2], v11[3]); *(u32x4*)(rowp + HALF) = w; }
                if (u.pn >= 3) {
                    float s0 = 0.f, s1 = 0.f;
#pragma unroll
                    for (int j = 0; j < 4; ++j) { s0 += v00[j] * v00[j] + v01[j] * v01[j]; s1 += v10[j] * v10[j] + v11[j] * v11[j]; }
                    if (u.pn == 3) { const float t = quad_sum(s0 + s1); if (fq == 0) statq[(size_t)row * 4 + wc] = t; }
                    else { const float t = quad_sum(s0); if (fq == 0) statkv[(size_t)row * 4 + wc] = t;
                        if (wc < 2) { const int g = 4 * wc + fq; const float* c = cs + ((size_t)(row & 2047) * 32 + 4 * g) * 2; const f32x4 c01 = *(const f32x4*)c, c23 = *(const f32x4*)(c + 4);
                            const float co[4] = {c01[0], c01[2], c23[0], c23[2]}, si[4] = {c01[1], c01[3], c23[1], c23[3]}; float y1[4], y2[4];
#pragma unroll
                            for (int j = 0; j < 4; ++j) { const float x1 = v10[j], x2 = v11[j]; y1[j] = x1 * co[j] - x2 * si[j]; y2[j] = x2 * co[j] + x1 * si[j]; }
                            u32x4 w; w.x = cvt_pk_bf16(y1[0], y1[1]); w.y = cvt_pk_bf16(y1[2], y1[3]); w.z = cvt_pk_bf16(y2[0], y2[1]); w.w = cvt_pk_bf16(y2[2], y2[3]);
                            *(u32x4*)(KR + (size_t)row * 64 + 8 * g) = w; } } }
                asm volatile("" ::: "memory"); }
    }
};
struct EpiQRope {
    static constexpr bool PERM = true, AFTER_DRAIN = false;
    bf16_t* O; const float* cs; const float* statq; PG8_LAS float* rsl; int ldc; float qscale;
    __device__ __forceinline__ void operator()(const f32x4 (&acc)[2][2][4][2], const Unit& u, int wr, int wc, int fr, int fq) const {
        const int row0 = u.pm * BM + wr * 64 + fr;
        panel_rstd<4>(statq, u.pm, 1.0f / 256.0f, rsl);
#pragma unroll
        for (int bj = 0; bj < 2; ++bj) { const int col0 = u.pn * BM + bj * HALF + wc * 32 + 8 * fq; const int off = col0 % 192; const bool rope = off >= 128; const int g = rope ? ((off - 128) >> 3) : 0;
#pragma unroll
            for (int ai = 0; ai < 2; ++ai)
#pragma unroll
                for (int m = 0; m < 4; ++m) { const int row = row0 + ai * HALF + m * 16; f32x4 v0 = acc[ai][bj][m][0], v1 = acc[ai][bj][m][1];
                    const float qs = qscale * rsl[wr * 64 + fr + ai * HALF + m * 16];
                    const float* c = cs + ((size_t)(row & 2047) * 32 + 4 * g) * 2; f32x4 c01 = *(const f32x4*)c, c23 = *(const f32x4*)(c + 4);
                    if (!rope) { c01 = (f32x4){1.f, 0.f, 1.f, 0.f}; c23 = c01; }
                    const float co[4] = {c01[0], c01[2], c23[0], c23[2]}, si[4] = {c01[1], c01[3], c23[1], c23[3]};
#pragma unroll
                    for (int j = 0; j < 4; ++j) { const float x1 = v0[j], x2 = v1[j]; v0[j] = (x1 * co[j] - x2 * si[j]) * qs; v1[j] = (x2 * co[j] + x1 * si[j]) * qs; }
                    u32x4 w; w.x = cvt_pk_bf16(v0[0], v0[1]); w.y = cvt_pk_bf16(v0[2], v0[3]); w.z = cvt_pk_bf16(v1[0], v1[1]); w.w = cvt_pk_bf16(v1[2], v1[3]);
                    *(u32x4*)(O + (size_t)row * ldc + col0) = w;
                    asm volatile("" ::: "memory"); } }
    }
};

template <class Epi, class Sched, bool ALIGN_EPI = false, bool SP2 = false>
__device__ __forceinline__ void gemm_phase(PG8_LAS unsigned char* lds, const Gemm g, const Sched& S, const Epi& E) {
    const int tid = threadIdx.x, wid = __builtin_amdgcn_readfirstlane(tid >> 6), lane = tid & 63, wr = wid >> 2, wc = wid & 3, fr = lane & 15, fq = lane >> 4;
    int Kop = g.K; asm volatile("" : "+s"(Kop));
    const int K = Kop, nt = K / BK;
    unsigned voffA[2], voffB[2];
#pragma unroll
    for (int i = 0; i < 2; ++i) { int R, C; stage_rc(tid * 16 + i * 8192, R, C); const int Rb = Epi::PERM ? ((R & ~31) + perm32(R & 31)) : R;
        voffA[i] = (unsigned)(R * g.lda + C) * 2u; voffB[i] = (unsigned)(Rb * K + C) * 2u; }
    const size_t kstep = (size_t)(BK * 2);
    const size_t hstep = (size_t)HALF * K * 2;
    const size_t tstep = 2 * hstep;
    const size_t hstepA = (size_t)HALF * g.lda * 2, tstepA = 2 * hstepA;
    const unsigned ldsw = (unsigned)wid * 1024u;
    const int aoff = lds_byte(wr * 64 + fr, fq * 8), boff = lds_byte(wc * 32 + fr, fq * 8);
#define PG8_SA(b, h) (((b) * 2 + (h)) * HTB)
#define PG8_SB(b, h) ((4 + (b) * 2 + (h)) * HTB)
#define PG8_STAGE(bufoff, gbase, voff) do { _Pragma("unroll") for (int _i = 0; _i < 2; ++_i) \
        __builtin_amdgcn_global_load_lds((const unsigned*)((const char*)(gbase) + (voff)[_i]), (PG8_LAS unsigned*)(lds + (bufoff) + ldsw + _i * 8192), 16, 0, 0); } while (0)
#define PG8_LDA(dst, b, h) do { _Pragma("unroll") for (int m = 0; m < 4; ++m) _Pragma("unroll") for (int k = 0; k < 2; ++k) dst[m][k] = *(const PG8_LAS bf16x8*)(lds + PG8_SA(b, h) + aoff + m * 2048 + k * 1024); } while (0)
#define PG8_LDB(dst, b, h) do { _Pragma("unroll") for (int n = 0; n < 2; ++n) _Pragma("unroll") for (int k = 0; k < 2; ++k) dst[n][k] = *(const PG8_LAS bf16x8*)(lds + PG8_SB(b, h) + boff + n * 2048 + k * 1024); } while (0)
#define PG8_MMA(ai, bj, At, Bt) do { __builtin_amdgcn_s_setprio(1); _Pragma("unroll") for (int m = 0; m < 4; ++m) _Pragma("unroll") for (int n = 0; n < 2; ++n) _Pragma("unroll") for (int k = 0; k < 2; ++k) \
        acc[ai][bj][m][n] = __builtin_amdgcn_mfma_f32_16x16x32_bf16(Bt[n][k], At[m][k], acc[ai][bj][m][n], 0, 0, 0); __builtin_amdgcn_s_setprio(0); } while (0)
#define PG8_WAIT_V(n) asm volatile("s_waitcnt vmcnt(" #n ")" ::: "memory")
#define PG8_WAIT_L(n) asm volatile("s_waitcnt lgkmcnt(" #n ")" ::: "memory")
#define PG8_BAR __builtin_amdgcn_s_barrier()
#define PG8_SCHED __builtin_amdgcn_sched_barrier(0)
    Unit cur, nxt; int ui = 0;
    if (!S.next(0, cur)) return;
    f32x4 acc[2][2][4][2];
#pragma unroll
    for (int a = 0; a < 2; ++a)
#pragma unroll
        for (int b = 0; b < 2; ++b)
#pragma unroll
            for (int m = 0; m < 4; ++m)
#pragma unroll
                for (int n = 0; n < 2; ++n) acc[a][b][m][n] = (f32x4){0.f, 0.f, 0.f, 0.f};
    bf16x8 At[4][2], B0[2][2], B1[2][2];
    const char* cA = (const char*)g.A + (size_t)cur.pm * tstepA; const char* cB = (const char*)g.Bt + (size_t)cur.pn * tstep;
    S.a_ready(cur);
    if constexpr (SP2) {
        PG8_STAGE(PG8_SB(0, 0), cB, voffB); PG8_STAGE(PG8_SB(0, 1), cB + hstep, voffB); PG8_STAGE(PG8_SA(0, 0), cA, voffA); PG8_STAGE(PG8_SA(0, 1), cA + hstepA, voffA);
        if (wr == 1) PG8_BAR;
        PG8_WAIT_V(2); PG8_BAR;
        PG8_STAGE(PG8_SB(1, 0), cB + kstep, voffB); PG8_STAGE(PG8_SA(1, 0), cA + kstep, voffA); PG8_STAGE(PG8_SB(1, 1), cB + hstep + kstep, voffB);
        PG8_WAIT_V(6); PG8_BAR;
    } else {
        PG8_STAGE(PG8_SB(0, 0), cB, voffB); PG8_STAGE(PG8_SA(0, 0), cA, voffA); PG8_STAGE(PG8_SB(0, 1), cB + hstep, voffB); PG8_STAGE(PG8_SA(0, 1), cA + hstepA, voffA);
        if (wr == 1) PG8_BAR;
        PG8_WAIT_V(4); PG8_BAR;
        PG8_STAGE(PG8_SB(1, 0), cB + kstep, voffB); PG8_STAGE(PG8_SA(1, 0), cA + kstep, voffA); PG8_STAGE(PG8_SB(1, 1), cB + hstep + kstep, voffB);
        PG8_WAIT_V(6); PG8_BAR;
    }
    for (;;) {
        const bool has_next = S.next(ui + 1, nxt);
        const char* nA = has_next ? (const char*)g.A + (size_t)nxt.pm * tstepA : cA; const char* nB = has_next ? (const char*)g.Bt + (size_t)nxt.pn * tstep : cB;
        for (int t = 0; t < nt; t += 2) {
            const bool last = (t == nt - 2);
            const char* a1 = cA + (size_t)(t + 1) * kstep;
            const char* a2 = last ? nA : cA + (size_t)(t + 2) * kstep; const char* b2 = last ? nB : cB + (size_t)(t + 2) * kstep;
            const char* a3 = a2 + kstep; const char* b3 = b2 + kstep;
            if (last && has_next) S.a_ready(nxt);
            if constexpr (SP2) {
            PG8_LDB(B0, 0, 0); PG8_LDB(B1, 0, 1); PG8_SCHED; PG8_LDA(At, 0, 0); PG8_STAGE(PG8_SA(1, 1), a1 + hstepA, voffA);
            PG8_WAIT_V(8); PG8_WAIT_L(0); PG8_BAR; PG8_MMA(0, 0, At, B0); PG8_MMA(0, 1, At, B1); PG8_BAR; PG8_SCHED;
            PG8_LDA(At, 0, 1); PG8_STAGE(PG8_SB(0, 0), b2, voffB); PG8_STAGE(PG8_SB(0, 1), b2 + hstep, voffB); PG8_STAGE(PG8_SA(0, 0), a2, voffA);
            PG8_WAIT_V(8); PG8_WAIT_L(0); PG8_BAR; PG8_MMA(1, 0, At, B0); PG8_MMA(1, 1, At, B1); PG8_BAR; PG8_SCHED;
            PG8_LDB(B0, 1, 0); PG8_LDB(B1, 1, 1); PG8_SCHED; PG8_LDA(At, 1, 0); PG8_STAGE(PG8_SA(0, 1), a2 + hstepA, voffA);
            PG8_WAIT_V(8); PG8_WAIT_L(0); PG8_BAR; PG8_MMA(0, 0, At, B0); PG8_MMA(0, 1, At, B1); PG8_BAR; PG8_SCHED;
            PG8_LDA(At, 1, 1); PG8_STAGE(PG8_SB(1, 0), b3, voffB); PG8_STAGE(PG8_SB(1, 1), b3 + hstep, voffB); PG8_STAGE(PG8_SA(1, 0), a3, voffA);
            PG8_WAIT_V(8); PG8_WAIT_L(0); PG8_BAR; PG8_MMA(1, 0, At, B0); PG8_MMA(1, 1, At, B1); PG8_BAR; PG8_SCHED;
            } else {
            PG8_LDB(B0, 0, 0); PG8_SCHED; PG8_LDA(At, 0, 0); PG8_STAGE(PG8_SA(1, 1), a1 + hstepA, voffA);
            PG8_WAIT_L(8); PG8_BAR; PG8_WAIT_L(0); PG8_MMA(0, 0, At, B0); PG8_BAR; PG8_SCHED;
            PG8_LDB(B1, 0, 1); PG8_STAGE(PG8_SB(0, 0), b2, voffB);
            PG8_BAR; PG8_WAIT_L(0); PG8_MMA(0, 1, At, B1); PG8_BAR;
            PG8_LDA(At, 0, 1); PG8_STAGE(PG8_SA(0, 0), a2, voffA);
            PG8_BAR; PG8_WAIT_L(0); PG8_MMA(1, 0, At, B0); PG8_BAR; PG8_SCHED;
            PG8_STAGE(PG8_SB(0, 1), b2 + hstep, voffB);
            PG8_WAIT_V(6); PG8_BAR; PG8_MMA(1, 1, At, B1); PG8_BAR;
            PG8_LDB(B0, 1, 0); PG8_SCHED; PG8_LDA(At, 1, 0); PG8_STAGE(PG8_SA(0, 1), a2 + hstepA, voffA);
            PG8_WAIT_L(8); PG8_BAR; PG8_WAIT_L(0); PG8_MMA(0, 0, At, B0); PG8_BAR; PG8_SCHED;
            PG8_LDB(B1, 1, 1); PG8_STAGE(PG8_SB(1, 0), b3, voffB);
            PG8_BAR; PG8_WAIT_L(0); PG8_MMA(0, 1, At, B1); PG8_BAR;
            PG8_LDA(At, 1, 1); PG8_STAGE(PG8_SA(1, 0), a3, voffA);
            PG8_BAR; PG8_WAIT_L(0); PG8_MMA(1, 0, At, B0); PG8_BAR; PG8_SCHED;
            PG8_STAGE(PG8_SB(1, 1), b3 + hstep, voffB);
            PG8_WAIT_V(6); PG8_BAR; PG8_MMA(1, 1, At, B1); PG8_BAR;
            }
        }
        if constexpr (ALIGN_EPI) { if (wr == 0) PG8_BAR; }
        E(acc, cur, wr, wc, fr, fq); S.done(cur);
        if (!has_next) break;
#pragma unroll
        for (int a = 0; a < 2; ++a)
#pragma unroll
            for (int b = 0; b < 2; ++b)
#pragma unroll
                for (int m = 0; m < 4; ++m)
#pragma unroll
                    for (int n = 0; n < 2; ++n) acc[a][b][m][n] = (f32x4){0.f, 0.f, 0.f, 0.f};
        cur = nxt; cA = nA; cB = nB; ++ui;
        if constexpr (ALIGN_EPI) { if (wr == 1) PG8_BAR; }
    }
    PG8_WAIT_V(0);
    if constexpr (!ALIGN_EPI) { if (wr == 0) PG8_BAR; }
    PG8_BAR;
#undef PG8_SA
#undef PG8_SB
#undef PG8_STAGE
#undef PG8_LDA
#undef PG8_LDB
#undef PG8_MMA
#undef PG8_WAIT_V
#undef PG8_WAIT_L
#undef PG8_BAR
#undef PG8_SCHED
}
}

namespace att {
#define ATT_LAS __attribute__((address_space(3)))
typedef unsigned short bf16_t;
typedef short bf16x8 __attribute__((ext_vector_type(8)));
typedef short s16x4 __attribute__((ext_vector_type(4)));
typedef float f32x16 __attribute__((ext_vector_type(16)));
typedef unsigned u32x4 __attribute__((ext_vector_type(4)));
#define ATT_SBAR() __builtin_amdgcn_sched_barrier(0)
__device__ __forceinline__ int crow(int r, int hi) { return (r & 3) + 8 * (r >> 2) + 4 * hi; }
__device__ __forceinline__ unsigned cvtpk(float lo, float hi) { unsigned r; asm volatile("v_cvt_pk_bf16_f32 %0, %1, %2" : "=v"(r) : "v"(lo), "v"(hi)); return r; }
template <int D> __device__ __forceinline__ int kswz(int row, int chunk) { return row * (D * 2) + ((chunk * 16) ^ ((D == 128 ? (row & 15) : ((row >> 1) & 7)) << 4)); }
template <int NCB> __device__ __forceinline__ int v_st(int k, int c) { const int kk = (k & ~0xC) | ((k & 4) << 1) | ((k & 8) >> 1); return ((kk >> 3) * NCB + (c >> 5)) * 512 + ((kk & 7) * 32 + (c & 31)) * 2; }
__device__ __forceinline__ int v_rd_base(int lane) { return ((lane & 3) << 3) | (((lane >> 2) & 3) << 6) | (((lane >> 4) & 1) << 5) | (((lane >> 5) & 1) << 8); }

template <int DN, int DR, int DV, bool SWA>
struct Body {
    static constexpr int KN_B = 64 * DN * 2, KR_B = 64 * DR * 2, V_B = 64 * DV * 2, K_B = KN_B + KR_B, BUF_B = K_B + V_B;
    static constexpr int NCB = DV / 32, GS = NCB * 512;
    static constexpr int NQ = (DN + DR) / 16;
    static constexpr int NCH_KN = 64 * DN / 8 / 512, NCH_KR = (DR > 0) ? 1 : 0, NCH_V = 64 * DV / 8 / 512;
    static constexpr int OFF_SCR = 2 * BUF_B, OFF_BIAS = OFF_SCR + 8 * 256, LDS_TOTAL = OFF_BIAS + 384 * 4;
    static_assert(DR == 0 || DR == 64, "rope dims");

    struct Stage { bf16x8 kn[NCH_KN]; bf16x8 kr[NCH_KR ? NCH_KR : 1]; bf16x8 v[NCH_V]; };

    __device__ static __forceinline__ void stage_load(Stage& S, const bf16_t* KN, int knp, const bf16_t* KR, int krp, const bf16_t* V, int vp, int kb, int tid) {
#pragma unroll
        for (int i = 0; i < NCH_KN; ++i) { const int ci = tid + 512 * i, row = ci / (DN / 8), ch = ci % (DN / 8); S.kn[i] = *(const bf16x8*)(KN + (size_t)(kb + row) * knp + ch * 8); }
        if constexpr (DR > 0) { const int row = tid >> 3, ch = tid & 7; S.kr[0] = *(const bf16x8*)(KR + (size_t)(kb + row) * krp + ch * 8); }
#pragma unroll
        for (int i = 0; i < NCH_V; ++i) { const int ci = tid + 512 * i, row = ci / (DV / 8), ch = ci % (DV / 8); S.v[i] = *(const bf16x8*)(V + (size_t)(kb + row) * vp + ch * 8); }
    }
    __device__ static __forceinline__ void stage_write(const Stage& S, ATT_LAS char* lds, int cur, int tid) {
        ATT_LAS char* kbuf = lds + 2 * V_B + cur * K_B; ATT_LAS char* vbuf = lds + cur * V_B;
#pragma unroll
        for (int i = 0; i < NCH_KN; ++i) { const int ci = tid + 512 * i, row = ci / (DN / 8), ch = ci % (DN / 8); *(ATT_LAS bf16x8*)(kbuf + kswz<DN>(row, ch)) = S.kn[i]; }
        if constexpr (DR > 0) { const int row = tid >> 3, ch = tid & 7; *(ATT_LAS bf16x8*)(kbuf + KN_B + kswz<64>(row, ch)) = S.kr[0]; }
#pragma unroll
        for (int i = 0; i < NCH_V; ++i) { const int ci = tid + 512 * i, row = ci / (DV / 8), ch = ci % (DV / 8); *(ATT_LAS bf16x8*)(vbuf + v_st<NCB>(row, ch * 8)) = S.v[i]; }
    }
    template <int D> __device__ static __forceinline__ void qk_acc(f32x16& p0, f32x16& p1, const ATT_LAS char* Kt, int r32, int hi, const bf16x8* qr) {
#pragma unroll
        for (int d0 = 0; d0 < D / 16; ++d0) { const ATT_LAS char* a = Kt + kswz<D>(r32, 2 * d0 + hi);
            const bf16x8 b0 = *(const ATT_LAS bf16x8*)a; const bf16x8 b1 = *(const ATT_LAS bf16x8*)(a + 32 * D * 2);
            p0 = __builtin_amdgcn_mfma_f32_32x32x16_bf16(b0, qr[d0], p0, 0, 0, 0);
            p1 = __builtin_amdgcn_mfma_f32_32x32x16_bf16(b1, qr[d0], p1, 0, 0, 0); }
    }
    template <int VOFF> __device__ static __forceinline__ void pv_tile(f32x16* o, int vaddr, bf16x8 pa0, bf16x8 pa1, bf16x8 pa2, bf16x8 pa3) {
#define ATT_TRRD(dst, off) asm volatile("ds_read_b64_tr_b16 %0, %1 offset:%2" : "=&v"(dst) : "v"(vaddr), "i"(off) : "memory")
#pragma unroll
        for (int d0 = 0; d0 < NCB; ++d0) { s16x4 l0, l1, l2, l3, h0, h1, h2, h3; const int b_ = VOFF + d0 * 512;
            ATT_TRRD(l0, b_); ATT_TRRD(h0, b_ + GS); ATT_TRRD(l1, b_ + 2 * GS); ATT_TRRD(h1, b_ + 3 * GS); ATT_TRRD(l2, b_ + 4 * GS); ATT_TRRD(h2, b_ + 5 * GS); ATT_TRRD(l3, b_ + 6 * GS); ATT_TRRD(h3, b_ + 7 * GS);
            asm volatile("s_waitcnt lgkmcnt(0)" ::: "memory"); ATT_SBAR();
            o[d0] = __builtin_amdgcn_mfma_f32_32x32x16_bf16(pa0, (bf16x8){l0[0], l0[1], l0[2], l0[3], h0[0], h0[1], h0[2], h0[3]}, o[d0], 0, 0, 0);
            o[d0] = __builtin_amdgcn_mfma_f32_32x32x16_bf16(pa1, (bf16x8){l1[0], l1[1], l1[2], l1[3], h1[0], h1[1], h1[2], h1[3]}, o[d0], 0, 0, 0);
            o[d0] = __builtin_amdgcn_mfma_f32_32x32x16_bf16(pa2, (bf16x8){l2[0], l2[1], l2[2], l2[3], h2[0], h2[1], h2[2], h2[3]}, o[d0], 0, 0, 0);
            o[d0] = __builtin_amdgcn_mfma_f32_32x32x16_bf16(pa3, (bf16x8){l3[0], l3[1], l3[2], l3[3], h3[0], h3[1], h3[2], h3[3]}, o[d0], 0, 0, 0); }
#undef ATT_TRRD
    }

    struct State { bf16x8 qr[NQ]; f32x16 o[NCB]; float m, l; };

    template <int CUR> __device__ static __forceinline__ void tile(State& st, ATT_LAS char* lds, int ldsaddr, int r32, int hi, int wid, int dq, unsigned W, bool needmask, float scl) {
        const ATT_LAS char* buf = lds + 2 * V_B + CUR * K_B;
        f32x16 p0 = {}, p1 = {};
        qk_acc<DN>(p0, p1, buf, r32, hi, st.qr);
        if constexpr (DR > 0) qk_acc<DR>(p0, p1, buf + KN_B, r32, hi, st.qr + DN / 16);
        if constexpr (SWA) {
            const ATT_LAS float* tl = (const ATT_LAS float*)(lds + OFF_BIAS) + (256 - dq);
#pragma unroll
            for (int r = 0; r < 16; ++r) { const int c = (r & 3) + 8 * (r >> 2); p0[r] = fmaf(p0[r], scl, tl[c]); p1[r] = fmaf(p1[r], scl, tl[c + 32]); }
        }
        if (needmask) { const float NEG = -__builtin_inff();
#pragma unroll
            for (int r = 0; r < 16; ++r) { const int c = (r & 3) + 8 * (r >> 2);
                if ((unsigned)(dq - c) >= W) p0[r] = NEG;
                if ((unsigned)(dq - c - 32) >= W) p1[r] = NEG; } }
        float pmax = p0[0];
#pragma unroll
        for (int r = 1; r < 16; ++r) pmax = fmaxf(pmax, p0[r]);
#pragma unroll
        for (int r = 0; r < 16; ++r) pmax = fmaxf(pmax, p1[r]);
        { auto rr = __builtin_amdgcn_permlane32_swap(__float_as_uint(pmax), __float_as_uint(pmax), false, false); pmax = fmaxf(__uint_as_float(rr[0]), __uint_as_float(rr[1])); }
        const float mn = fmaxf(st.m, pmax); const float alpha = __builtin_amdgcn_exp2f(st.m - mn); st.m = mn;
        float ps = 0.f;
#pragma unroll
        for (int r = 0; r < 16; ++r) { p0[r] = __builtin_amdgcn_exp2f(p0[r] - mn); p1[r] = __builtin_amdgcn_exp2f(p1[r] - mn); ps += p0[r] + p1[r]; }
        { auto rr = __builtin_amdgcn_permlane32_swap(__float_as_uint(ps), __float_as_uint(ps), false, false); ps = __uint_as_float(rr[0]) + __uint_as_float(rr[1]); }
        st.l = st.l * alpha + ps;
        bf16x8 pa0, pa1, pa2, pa3;
#define ATT_PK4(P, B_, OUT) do { unsigned a0 = cvtpk(P[B_ + 0], P[B_ + 1]), a1 = cvtpk(P[B_ + 2], P[B_ + 3]); unsigned b0 = cvtpk(P[B_ + 4], P[B_ + 5]), b1 = cvtpk(P[B_ + 6], P[B_ + 7]); \
        auto r0 = __builtin_amdgcn_permlane32_swap(a0, b0, false, false); auto r1 = __builtin_amdgcn_permlane32_swap(a1, b1, false, false); \
        u32x4 w = {r0[0], r1[0], r0[1], r1[1]}; OUT = *reinterpret_cast<bf16x8*>(&w); } while (0)
        ATT_PK4(p0, 0, pa0); ATT_PK4(p0, 8, pa1); ATT_PK4(p1, 0, pa2); ATT_PK4(p1, 8, pa3);
#undef ATT_PK4
        if (__any(alpha < 1.f)) { ATT_LAS float* al = (ATT_LAS float*)(lds + OFF_SCR) + wid * 64;
            if (hi == 0) al[r32] = alpha;
            asm volatile("s_waitcnt lgkmcnt(0)" ::: "memory");
#pragma unroll
            for (int r = 0; r < 16; ++r) { const float a = al[crow(r, hi)];
#pragma unroll
                for (int d0 = 0; d0 < NCB; ++d0) st.o[d0][r] *= a; }
            asm volatile("s_waitcnt lgkmcnt(0)" ::: "memory"); }
        ATT_SBAR();
        pv_tile<CUR * V_B>(st.o, ldsaddr, pa0, pa1, pa2, pa3);
    }

    __device__ static __forceinline__ void unit(ATT_LAS char* lds, const bf16_t* Qrow, int qpitch, const bf16_t* KN, int knp, const bf16_t* KR, int krp, const bf16_t* V, int vp,
                                                bf16_t* Orow, int opitch, int r0, int kb0, int NT, unsigned W, float scl, float sinkl2) {
        const int tid = threadIdx.x, lane = tid & 63, r32 = lane & 31, hi = lane >> 5; const int wid = __builtin_amdgcn_readfirstlane(tid >> 6);
        const int ldsaddr = (int)(unsigned)(uintptr_t)lds + v_rd_base(lane);
        State st;
#pragma unroll
        for (int d0 = 0; d0 < NQ; ++d0) st.qr[d0] = *(const bf16x8*)(Qrow + (size_t)r32 * qpitch + d0 * 16 + hi * 8);
#pragma unroll
        for (int d0 = 0; d0 < NCB; ++d0) st.o[d0] = f32x16{};
        st.m = -1e30f; st.l = 0.f;
        Stage sg;
        stage_load(sg, KN, knp, KR, krp, V, vp, kb0, tid);
        stage_write(sg, lds, 0, tid);
        __syncthreads();
        const int rowpos = r0 + r32;
#define ATT_STEP(CUR, t) do { const int kb_ = kb0 + 64 * (t); const bool more_ = (t) + 1 < NT; \
        if (more_) stage_load(sg, KN, knp, KR, krp, V, vp, kb_ + 64, tid); \
        const bool act_ = (kb_ <= r0 + 31) && ((long)kb_ + 63 >= (long)r0 - (long)(W - 1u)); \
        if (act_) { const bool nm_ = SWA || (kb_ + 63 > r0); tile<CUR>(st, lds, ldsaddr, r32, hi, wid, rowpos - kb_ - 4 * hi, W, nm_, scl); } \
        if (more_) stage_write(sg, lds, (CUR) ^ 1, tid); \
        __syncthreads(); } while (0)
        int t = 0;
        for (; t + 1 < NT; t += 2) { ATT_STEP(0, t); ATT_STEP(1, t + 1); }
        if (t < NT) { ATT_STEP(0, t); }
#undef ATT_STEP
        if constexpr (SWA) st.l += __builtin_amdgcn_exp2f(sinkl2 - st.m);
        ATT_LAS float* li = (ATT_LAS float*)(lds + OFF_SCR) + wid * 64 + 32;
        if (hi == 0) li[r32] = st.l;
        asm volatile("s_waitcnt lgkmcnt(0)" ::: "memory");
        float rli[16];
#pragma unroll
        for (int r = 0; r < 16; ++r) rli[r] = __builtin_amdgcn_rcpf(li[crow(r, hi)]);
#pragma unroll
        for (int r = 0; r < 16; ++r) { const int orow = crow(r, hi);
#pragma unroll
            for (int d0 = 0; d0 < NCB; ++d0) { const float v = st.o[d0][r] * rli[r]; const float vn = __shfl_xor(v, 1);
                if ((r32 & 1) == 0) *(unsigned*)(Orow + (size_t)orow * opitch + d0 * 32 + r32) = cvtpk(v, vn); } }
        __syncthreads();
    }
};
}

constexpr int D_MODEL = 1024, BATCH = 8, SEQ = 2048, M = BATCH * SEQ, D_FF = 2816, N_MOD = 9;
constexpr int D_IN = 1216, D_IN_PAD = 1280;
constexpr float EPS = 1e-6f;
constexpr float L2E = 1.4426950408889634f;
constexpr int NWAVES = 8;

constexpr size_t MiB = 1u << 20;
constexpr size_t WS_CTL = 0;
constexpr size_t WS_MOD = 1 * MiB;
constexpr size_t WS_ROPE = 2 * MiB;
constexpr size_t WS_W1GU = 4 * MiB;
constexpr size_t WS_W1D = 15 * MiB;
constexpr size_t WS_W2GU = 21 * MiB;
constexpr size_t WS_W2D = 32 * MiB;
constexpr size_t WS_WIN = 38 * MiB;
constexpr size_t WS_WO = 41 * MiB;
constexpr size_t WS_WUQ = 43 * MiB;
constexpr size_t WS_WUKV = 44 * MiB;
constexpr size_t WS_H = 46 * MiB;
constexpr size_t WS_ACT = 78 * MiB;
constexpr size_t WS_PROJ = 78 * MiB;
constexpr size_t WS_Q = 118 * MiB;
constexpr size_t WS_KV = 142 * MiB;
constexpr size_t WS_MIX = 174 * MiB;
constexpr size_t WS_QN = 206 * MiB;
constexpr size_t WS_KVN = 214 * MiB;
constexpr size_t WS_KR = 218 * MiB;
constexpr size_t WS_STATX = 220 * MiB;
constexpr size_t WS_STATQ = 221 * MiB;
constexpr size_t WS_STATKV = 221 * MiB + 512 * 1024;
constexpr size_t WS_BIAS2 = 222 * MiB;
constexpr size_t WS_BIAS3 = 222 * MiB + 256 * 1024;
constexpr size_t WS_END = 224 * MiB;

constexpr int LDS_BYTES = 147456;

typedef unsigned short bf16;
typedef float f32x4 __attribute__((ext_vector_type(4)));
typedef unsigned v4u __attribute__((ext_vector_type(4)));
typedef short bf16x8 __attribute__((ext_vector_type(8)));
#define LAS __attribute__((address_space(3)))

__device__ __forceinline__ unsigned f2bf(float f) { unsigned u = __builtin_bit_cast(unsigned, f); return (u + 0x7fffu + ((u >> 16) & 1u)) >> 16; }
__device__ __forceinline__ unsigned pk2(float lo, float hi) { return f2bf(lo) | (f2bf(hi) << 16); }
__device__ __forceinline__ float bf2f(unsigned short h) { return __builtin_bit_cast(float, (unsigned)h << 16); }
__device__ __forceinline__ float wave_sum(float v) {
#pragma unroll
    for (int o = 1; o < 64; o <<= 1) v += __shfl_xor(v, o);
    return v;
}

typedef __attribute__((address_space(1))) unsigned gu32;
#define RLX_AGENT __ATOMIC_RELAXED, __HIP_MEMORY_SCOPE_AGENT
#define XB_TMO      128
#define XB_XCNT(j)  (256  + 64 * (j))
#define XB_XSUB(j)  (1280 + 64 * (j))
#define XB_XGEN(j)  (2304 + 64 * (j))
#define XB_TOP      3328
#define XB_TOPGEN   3392
#define XCD_BAR_WORDS 3456
#define XB_SPIN_CAP (1u << 18)

__device__ __forceinline__ unsigned xb_ld(unsigned* p)              { return __hip_atomic_load(p, __ATOMIC_RELAXED, __HIP_MEMORY_SCOPE_AGENT); }
__device__ __forceinline__ unsigned xb_add(unsigned* p, unsigned v) { return __hip_atomic_fetch_add(p, v, __ATOMIC_RELAXED, __HIP_MEMORY_SCOPE_AGENT); }
__device__ __forceinline__ unsigned xb_xcc_id() { return (unsigned)__builtin_amdgcn_s_getreg((3 << 11) | 20) & 0xFu; }
#define XB_SPIN(cond, bar) do { unsigned _sp = 0; while (cond) { __builtin_amdgcn_s_sleep(1); \
    if ((++_sp & 255u) == 0u) { if (xb_ld(&(bar)[XB_TMO])) break; if (_sp > XB_SPIN_CAP) { atomicAdd(&(bar)[XB_TMO], 1u); break; } } } } while (0)

struct XcdBarrier {
    unsigned* bar; unsigned x;
    volatile LAS unsigned* st;
};

__device__ __forceinline__ XcdBarrier xcd_barrier_post(unsigned* bar, volatile LAS unsigned* st) {
    XcdBarrier b; b.bar = bar; b.x = xb_xcc_id(); b.st = st;
    if (threadIdx.x == 0) (void)xb_add(&bar[XB_XCNT(b.x)], 1u);
    return b;
}
__device__ __forceinline__ void xcd_barrier_complete(unsigned* bar, unsigned x, unsigned& nloc, unsigned& nx) {
    const unsigned G = gridDim.x * gridDim.y * gridDim.z;
    unsigned sum, cnt, mine, sp = 0u;
    for (;;) {
        sum = 0u; cnt = 0u; mine = 0u;
#pragma unroll
        for (unsigned j = 0; j < 16; ++j) { const unsigned c = xb_ld(&bar[XB_XCNT(j)]); sum += c; cnt += (c > 0u) ? 1u : 0u; mine = (j == x) ? c : mine; }
        if (sum == G) break;
        __builtin_amdgcn_s_sleep(1);
        if ((++sp & 255u) == 0u) { if (xb_ld(&bar[XB_TMO])) break; if (sp > XB_SPIN_CAP) { atomicAdd(&bar[XB_TMO], 1u); break; } }
    }
    nloc = mine > 0u ? mine : 1u; nx = cnt > 0u ? cnt : 1u;
}

__device__ __forceinline__ void xcd_barrier(const XcdBarrier& b) {
    asm volatile("s_waitcnt vmcnt(0)" ::: "memory");
    __syncthreads();
    if (threadIdx.x == 0) {
        unsigned* bar = b.bar;
        __builtin_amdgcn_s_waitcnt(0);
        unsigned nloc = b.st[0], nx = b.st[1];
        if (nloc == 0u) { xcd_barrier_complete(bar, b.x, nloc, nx); b.st[0] = nloc; b.st[1] = nx; }
        const unsigned old = xb_add(&bar[XB_XSUB(b.x)], 1u);
        const unsigned gen = old / nloc;
        if (old + 1u == (gen + 1u) * nloc) {
            __builtin_amdgcn_fence(__ATOMIC_RELEASE, "agent");
            asm volatile("s_waitcnt vmcnt(0)" ::: "memory");
            const unsigned og = xb_add(&bar[XB_TOP], 1u);
            const unsigned tg = og / nx;
            if (og + 1u == (tg + 1u) * nx) xb_add(&bar[XB_TOPGEN], 1u);
            else XB_SPIN(xb_ld(&bar[XB_TOPGEN]) == tg, bar);
            __builtin_amdgcn_fence(__ATOMIC_ACQUIRE, "agent");
            xb_add(&bar[XB_XGEN(b.x)], 1u);
            asm volatile("s_waitcnt vmcnt(0)" ::: "memory");
        } else {
            XB_SPIN(xb_ld(&bar[XB_XGEN(b.x)]) == gen, bar);
            __builtin_amdgcn_fence(__ATOMIC_ACQUIRE, "agent");
            asm volatile("s_waitcnt vmcnt(0)" ::: "memory");
        }
    }
    __syncthreads();
}

struct Args {
    const float* in[22]; float* out; unsigned char* ws; int ph_lo, ph_hi;
};

template <class RowMap>
__device__ __forceinline__ void transpose_item(const float* W, int K, int N, bf16* WT, LAS float* scr, int item, int lane, RowMap rm, const float* kgain = nullptr) {
    const int nblk = N / 32, kb = item / nblk, nb = item % nblk, k0 = 64 * kb, n0 = 32 * nb;
#pragma unroll 8
    for (int i = 0; i < 32; ++i) { const int kk = 2 * i + (lane >> 5); float wv = W[(size_t)(k0 + kk) * N + n0 + (lane & 31)]; if (kgain) wv *= kgain[k0 + kk]; scr[kk * 33 + (lane & 31)] = wv; }
    asm volatile("s_waitcnt lgkmcnt(0)" ::: "memory");
    const int c = lane & 7;
#pragma unroll
    for (int j = 0; j < 4; ++j) { const int n = (lane >> 3) + 8 * j; const LAS float* s = scr + (8 * c) * 33 + n;
        v4u o; o.x = pk2(s[0 * 33], s[1 * 33]); o.y = pk2(s[2 * 33], s[3 * 33]); o.z = pk2(s[4 * 33], s[5 * 33]); o.w = pk2(s[6 * 33], s[7 * 33]);
        *(v4u*)(WT + (size_t)rm(n0 + n) * K + k0 + 8 * c) = o; }
    asm volatile("s_waitcnt lgkmcnt(0)" ::: "memory");
}
struct RmId { __device__ __forceinline__ int operator()(int n) const { return n; } };
struct RmGU { int sel; __device__ __forceinline__ int operator()(int n) const { return (n >> 7) * 256 + sel * 128 + (n & 127); } };
struct RmIn { __device__ __forceinline__ int operator()(int n) const { if (n < 1152) return n; int i = n - 1152; if (i < 32) return 1152 + 8 * (i >> 2) + (i & 3); i -= 32; return 1152 + 8 * (i >> 2) + 4 + (i & 3); } };
struct RmUq { __device__ __forceinline__ int operator()(int n) const { const int h = n / 192, off = n % 192; if (off < 128) return n; int i = off - 128; int pos;
        if (i < 32) pos = 8 * (i >> 2) + (i & 3); else { i -= 32; pos = 8 * (i >> 2) + 4 + (i & 3); } return 192 * h + 128 + pos; } };

__device__ __forceinline__ int t5_bucket(int dist) {
    if (dist < 16) return dist;
    const float v = __logf((float)dist * (1.0f / 16.0f)) * (16.0f / 2.0794415416798357f);
    int b = 16 + (int)v; return b > 31 ? 31 : b;
}

__device__ __forceinline__ unsigned char* ld_ptr(LAS unsigned long long* ptab, int i) {
    const unsigned long long v = ptab[i];
    const unsigned lo = __builtin_amdgcn_readfirstlane((unsigned)v), hi = __builtin_amdgcn_readfirstlane((unsigned)(v >> 32));
    return (unsigned char*)(__attribute__((address_space(1))) unsigned char*)(uintptr_t)(((unsigned long long)hi << 32) | lo);
}
__device__ __forceinline__ void modnorm(const float* src, const float* gain, const float* MOD, int chunk, bf16* H, int gw, int NGW, int lane) {
    for (int r8 = gw; r8 < M / 8; r8 += NGW) {
        const int row0 = r8 * 8, b = row0 / SEQ;
        const float* shp = MOD + (size_t)b * (N_MOD * D_MODEL) + (size_t)chunk * D_MODEL; const float* scp = shp + D_MODEL;
        f32x4 gg[4], sh[4];
#pragma unroll
        for (int j = 0; j < 4; ++j) { const f32x4 g = ((const f32x4*)gain)[lane + 64 * j], sc = ((const f32x4*)scp)[lane + 64 * j]; gg[j] = g * (1.0f + sc); sh[j] = ((const f32x4*)shp)[lane + 64 * j]; }
        for (int rr = 0; rr < 8; ++rr) { const int row = row0 + rr;
            const f32x4* xr = (const f32x4*)(src + (size_t)row * D_MODEL) + lane;
            f32x4 v[4]; float s = 0.f;
#pragma unroll
            for (int j = 0; j < 4; ++j) { v[j] = xr[64 * j]; s += (v[j].x * v[j].x + v[j].y * v[j].y) + (v[j].z * v[j].z + v[j].w * v[j].w); }
            const float rstd = 1.0f / sqrtf(wave_sum(s) * (1.0f / D_MODEL) + EPS);
            unsigned long long* o8 = (unsigned long long*)(H + (size_t)row * D_MODEL) + lane;
#pragma unroll
            for (int j = 0; j < 4; ++j) { const f32x4 y = v[j] * rstd * gg[j] + sh[j];
                o8[64 * j] = (unsigned long long)pk2(y.x, y.y) | ((unsigned long long)pk2(y.z, y.w) << 32); } }
    }
}
__device__ __forceinline__ void biasgemv(const bf16* WT, int N, const float* MOD, int chunk, float* BIAS, int gw, int NGW, int lane) {
    float shv[8][16];
#pragma unroll
    for (int b = 0; b < 8; ++b)
#pragma unroll
        for (int c = 0; c < 2; ++c) { const float* sp = MOD + (size_t)b * (N_MOD * D_MODEL) + (size_t)chunk * D_MODEL + c * 512 + 8 * lane; const f32x4 a = *(const f32x4*)sp, d = *(const f32x4*)(sp + 4);
            shv[b][c * 8 + 0] = a[0]; shv[b][c * 8 + 1] = a[1]; shv[b][c * 8 + 2] = a[2]; shv[b][c * 8 + 3] = a[3]; shv[b][c * 8 + 4] = d[0]; shv[b][c * 8 + 5] = d[1]; shv[b][c * 8 + 6] = d[2]; shv[b][c * 8 + 7] = d[3]; }
    for (int n = gw; n < N; n += NGW) { const bf16* wr_ = WT + (size_t)n * D_MODEL + 8 * lane; const bf16x8 w0 = *(const bf16x8*)wr_, w1 = *(const bf16x8*)(wr_ + 512); float wf[16];
#pragma unroll
        for (int j = 0; j < 8; ++j) { wf[j] = bf2f((unsigned short)w0[j]); wf[8 + j] = bf2f((unsigned short)w1[j]); }
#pragma unroll
        for (int b = 0; b < 8; ++b) { float sacc = 0.f;
#pragma unroll
            for (int j = 0; j < 16; ++j) sacc = fmaf(wf[j], shv[b][j], sacc);
            sacc = wave_sum(sacc); if (lane == 0) BIAS[(size_t)b * N + n] = sacc; } }
}

template <int SET>
__device__ __forceinline__ void transpose_set(LAS unsigned long long* ptab, LAS float* scr, int gwf, int NGWF, int lane) {
#define LDPT(i) ((const float*)ld_ptr(ptab, (i)))
#define WSPT(off) ((bf16*)(ld_ptr(ptab, 23) + (off)))
    constexpr int I_GU = (D_MODEL / 64) * (D_FF / 32), I_D = (D_FF / 64) * (D_MODEL / 32), I_IN = (D_MODEL / 64) * (D_IN / 32), I_O = (D_MODEL / 64) * (D_MODEL / 32),
                  I_UQ = (256 / 64) * (768 / 32), I_UKV = (128 / 64) * (1024 / 32);
    if constexpr (SET == 1) {
        for (int it = gwf; it < 2 * I_GU + I_IN; it += NGWF) { int r = it;
            if (r < I_GU) { transpose_item(LDPT(5), D_MODEL, D_FF, WSPT(WS_W1GU), scr, r, lane, RmGU{0}); continue; } r -= I_GU;
            if (r < I_GU) { transpose_item(LDPT(6), D_MODEL, D_FF, WSPT(WS_W1GU), scr, r, lane, RmGU{1}); continue; } r -= I_GU;
            transpose_item(LDPT(9), D_MODEL, D_IN, WSPT(WS_WIN), scr, r, lane, RmIn{}); }
    } else if constexpr (SET == 2) {
        for (int it = gwf; it < I_D + I_O + I_UQ + I_UKV + 2 * I_GU; it += NGWF) { int r = it;
            if (r < I_D) { transpose_item(LDPT(7), D_FF, D_MODEL, WSPT(WS_W1D), scr, r, lane, RmId{}); continue; } r -= I_D;
            if (r < I_O) { transpose_item(LDPT(15), D_MODEL, D_MODEL, WSPT(WS_WO), scr, r, lane, RmId{}); continue; } r -= I_O;
            if (r < I_UQ) { transpose_item(LDPT(12), 256, 768, WSPT(WS_WUQ), scr, r, lane, RmUq{}, LDPT(10)); continue; } r -= I_UQ;
            if (r < I_UKV) { transpose_item(LDPT(13), 128, 1024, WSPT(WS_WUKV), scr, r, lane, RmId{}, LDPT(11)); continue; } r -= I_UKV;
            if (r < I_GU) { transpose_item(LDPT(17), D_MODEL, D_FF, WSPT(WS_W2GU), scr, r, lane, RmGU{0}); continue; } r -= I_GU;
            transpose_item(LDPT(18), D_MODEL, D_FF, WSPT(WS_W2GU), scr, r, lane, RmGU{1}); }
    } else {
        for (int it = gwf; it < I_D; it += NGWF) transpose_item(LDPT(19), D_FF, D_MODEL, WSPT(WS_W2D), scr, it, lane, RmId{});
    }
#undef LDPT
#undef WSPT
}

__global__ void __launch_bounds__(NWAVES * 64, 2) fwd_kernel(Args args) {
    extern __shared__ __attribute__((aligned(16))) unsigned char lds_raw[];
    LAS unsigned char* lds = (LAS unsigned char*)lds_raw;
    const int tid = threadIdx.x, lane = tid & 63, wave = __builtin_amdgcn_readfirstlane(tid >> 6);
    const int G = gridDim.x, bx = blockIdx.x;
    const int vcu = (G % 8 == 0) ? (bx % 8) * (G / 8) + bx / 8 : bx;
    const int gw = vcu * NWAVES + wave, NGW = G * NWAVES;
    volatile LAS unsigned* MISC = (volatile LAS unsigned*)(lds + 131072 + 320);
    LAS unsigned long long* ptab = (LAS unsigned long long*)(lds + 131072 + 1024);
    for (int u = tid; u < (LDS_BYTES - 131072) / 4; u += NWAVES * 64) ((LAS unsigned*)(lds + 131072))[u] = 0u;
    __syncthreads();
    if (tid < 22) ptab[tid] = (unsigned long long)(uintptr_t)args.in[tid];
    if (tid == 22) ptab[22] = (unsigned long long)(uintptr_t)args.out;
    if (tid == 23) ptab[23] = (unsigned long long)(uintptr_t)args.ws;
    __syncthreads();
    XcdBarrier bar = xcd_barrier_post((unsigned*)(args.ws + WS_CTL) + 4096, MISC + 8);
#define LDP(i) ((const float*)ld_ptr(ptab, (i)))
#define WSP(T, off) ((T*)(ld_ptr(ptab, 23) + (off)))
#define XOUT ((float*)ld_ptr(ptab, 22))
#define RSL ((LAS float*)(lds + 131072 + 2048))
    const int lo = args.ph_lo, hi = args.ph_hi;
#ifndef PH_MASK
#define PH_MASK 0xFFFFFFFFu
#endif
#define IN(k) (((PH_MASK >> (k)) & 1u) && lo <= (k) && (k) < hi)
#ifndef PROBE_DBL
#define PROBE_DBL 0u
#endif
#ifndef PROBE_SYNCS
#define PROBE_SYNCS 0
#endif
#define PHASE(k) for (int rep_ = 0; rep_ < (IN(k) ? 1 + (int)((PROBE_DBL >> (k)) & 1u) : 0); ++rep_)
#define SEAM(k) do { if (IN(k) && IN((k) + 1)) xcd_barrier(bar); } while (0)

    PHASE(0) { const float* c_in = LDP(1); const float* w_mod = LDP(2); const float* b_mod = LDP(3); float* MOD = WSP(float, WS_MOD);
        for (int u = bx; u < (N_MOD * D_MODEL) / 64; u += G) {
            LAS float* sact = (LAS float*)lds;
            LAS float* part = (LAS float*)(lds + 32768);
            for (int i = tid; i < BATCH * D_MODEL; i += NWAVES * 64) { const float v = c_in[i]; sact[i] = v / (1.0f + __expf(-v)); }
            __syncthreads();
            const int n = 64 * u + lane; float acc[8];
#pragma unroll
            for (int b = 0; b < 8; ++b) acc[b] = 0.f;
            const float* wp = w_mod + (size_t)(128 * wave) * (N_MOD * D_MODEL) + n;
#pragma unroll 8
            for (int k = 0; k < 128; ++k) { const float wv = wp[(size_t)k * (N_MOD * D_MODEL)];
#pragma unroll
                for (int b = 0; b < 8; ++b) acc[b] = fmaf(sact[b * 1024 + 128 * wave + k], wv, acc[b]); }
#pragma unroll
            for (int b = 0; b < 8; ++b) part[(wave * 8 + b) * 64 + lane] = acc[b];
            __syncthreads();
            { const int b = tid >> 6; float s = 0.f;
#pragma unroll
              for (int w = 0; w < 8; ++w) s += part[(w * 8 + b) * 64 + lane];
              MOD[(size_t)b * (N_MOD * D_MODEL) + n] = s + b_mod[n]; }
            __syncthreads();
        }
    }
    SEAM(0);
    for (int es_ = 0; es_ < PROBE_SYNCS; ++es_) xcd_barrier(bar);

    PHASE(1) { const float* x_in = LDP(0); const float* norm_ffn1 = LDP(4); float* MOD = WSP(float, WS_MOD); bf16* H = WSP(bf16, WS_H); float* ROPE = WSP(float, WS_ROPE); bf16* WIN = WSP(bf16, WS_WIN);
        transpose_set<1>(ptab, (LAS float*)(lds + wave * 16384), gw, NGW, lane);
        for (int i = bx * (NWAVES * 64) + tid; i < (D_IN_PAD - D_IN) * D_MODEL / 8; i += G * NWAVES * 64) ((v4u*)(WIN + (size_t)D_IN * D_MODEL))[i] = (v4u){0u, 0u, 0u, 0u};
        for (int idx = bx * (NWAVES * 64) + tid; idx < SEQ * 32; idx += G * NWAVES * 64) { const int p_ = idx >> 5, i = idx & 31;
            const float inv = powf(10000.0f, -(float)(2 * i) / 64.0f); const float ang = (float)p_ * inv;
            ROPE[2 * idx] = cosf(ang); ROPE[2 * idx + 1] = sinf(ang); }
        modnorm(x_in, norm_ffn1, MOD, 0, H, gw, NGW, lane); }
    SEAM(1);
    PHASE(2) { bf16* H = WSP(bf16, WS_H); bf16* W1GU = WSP(bf16, WS_W1GU); bf16* ACT = WSP(bf16, WS_ACT); pg8::Gemm g{H, W1GU, M, 2 * D_FF, D_MODEL, D_MODEL}; pg8::StaticOrder S; S.init(M, 2 * D_FF, G, bx); pg8::EpiSwiglu<false> E{ACT, nullptr, nullptr, RSL, D_FF};
        pg8::gemm_phase<pg8::EpiSwiglu<false>, pg8::StaticOrder, true, true>(lds, g, S, E);
        { constexpr int REM = (64 * 22) % 256; if (G == 256 && bx >= REM) { const int gwf = (bx - REM) * NWAVES + wave, NGWF = (256 - REM) * NWAVES;
            transpose_set<2>(ptab, (LAS float*)(lds + wave * 16384), gwf, NGWF, lane);
            biasgemv(WSP(bf16, WS_WIN), D_IN_PAD, WSP(float, WS_MOD), 3, WSP(float, WS_BIAS2), gwf, NGWF, lane); }
          else if (G != 256) { transpose_set<2>(ptab, (LAS float*)(lds + wave * 16384), gw, NGW, lane); biasgemv(WSP(bf16, WS_WIN), D_IN_PAD, WSP(float, WS_MOD), 3, WSP(float, WS_BIAS2), gw, NGW, lane); } } }
    SEAM(2);
    PHASE(3) { bf16* ACT = WSP(bf16, WS_ACT); bf16* W1D = WSP(bf16, WS_W1D); const float* x_in = LDP(0); float* X = XOUT; float* MOD = WSP(float, WS_MOD); const float* norm_mix = LDP(8); bf16* H = WSP(bf16, WS_H); float* STATX = WSP(float, WS_STATX); pg8::Gemm g{ACT, W1D, M, D_MODEL, D_FF, D_FF}; pg8::StaticOrder S; S.init(M, D_MODEL, G, bx);
        pg8::EpiResid<true> E{x_in, X, MOD + 2 * D_MODEL, norm_mix, MOD + 4 * D_MODEL, H, STATX, 0.5f};
        pg8::gemm_phase<pg8::EpiResid<true>, pg8::StaticOrder, true, true>(lds, g, S, E); }
    SEAM(3);
    PHASE(4) { bf16* H = WSP(bf16, WS_H); bf16* WIN = WSP(bf16, WS_WIN); bf16* PROJ = WSP(bf16, WS_PROJ); float* STATX = WSP(float, WS_STATX); float* BIAS2 = WSP(float, WS_BIAS2); float* STATQ = WSP(float, WS_STATQ); float* STATKV = WSP(float, WS_STATKV); bf16* KR = WSP(bf16, WS_KR); float* ROPE = WSP(float, WS_ROPE); pg8::Gemm g{H, WIN, M, D_IN_PAD, D_MODEL, D_MODEL}; pg8::StaticOrder S; S.init(M, D_IN_PAD, G, bx); pg8::EpiProj E{PROJ, STATX, BIAS2, STATQ, STATKV, KR, ROPE, RSL};
        pg8::gemm_phase<pg8::EpiProj, pg8::StaticOrder, true, true>(lds, g, S, E);
        { constexpr int REM = (64 * 5) % 256; if (G == 256 && bx >= REM) { const int gwf = (bx - REM) * NWAVES + wave, NGWF = (256 - REM) * NWAVES;
            transpose_set<3>(ptab, (LAS float*)(lds + wave * 16384), gwf, NGWF, lane);
            biasgemv(WSP(bf16, WS_W2GU), 2 * D_FF, WSP(float, WS_MOD), 6, WSP(float, WS_BIAS3), gwf, NGWF, lane); }
          else if (G != 256) { transpose_set<3>(ptab, (LAS float*)(lds + wave * 16384), gw, NGW, lane); biasgemv(WSP(bf16, WS_W2GU), 2 * D_FF, WSP(float, WS_MOD), 6, WSP(float, WS_BIAS3), gw, NGW, lane); } } }
    SEAM(4);
    PHASE(5) { bf16* PROJ = WSP(bf16, WS_PROJ); bf16* WUQ = WSP(bf16, WS_WUQ); bf16* Qb = WSP(bf16, WS_Q); float* ROPE = WSP(float, WS_ROPE); float* STATQ = WSP(float, WS_STATQ); bf16* WUKV = WSP(bf16, WS_WUKV); bf16* KV = WSP(bf16, WS_KV); float* STATKV = WSP(float, WS_STATKV);
        { pg8::Gemm g{PROJ + 768, WUQ, M, 768, 256, D_IN_PAD}; pg8::StaticOrder S; S.init(M, 768, G, bx); pg8::EpiQRope E{Qb, ROPE, STATQ, RSL, 768, 0.07216878364870322f * L2E};
          pg8::gemm_phase<pg8::EpiQRope, pg8::StaticOrder, true, true>(lds, g, S, E); }
        { pg8::Gemm g{PROJ + 1024, WUKV, M, 1024, 128, D_IN_PAD}; pg8::StaticOrder S; S.init(M, 1024, G, bx); pg8::EpiBf16<true> E{KV, STATKV, RSL, 1024, 1.0f / 128.0f};
          pg8::gemm_phase<pg8::EpiBf16<true>, pg8::StaticOrder, true, true>(lds, g, S, E); }
    }
    SEAM(5);
    PHASE(6) { bf16* Qb = WSP(bf16, WS_Q); bf16* KV = WSP(bf16, WS_KV); bf16* KR = WSP(bf16, WS_KR); bf16* MIX = WSP(bf16, WS_MIX); bf16* PROJ = WSP(bf16, WS_PROJ); const float* rel_bias = LDP(20); const float* sinks = LDP(14);
        LAS char* alds = (LAS char*)lds;
        {
            typedef att::Body<128, 64, 128, false> B;
            static_assert(B::LDS_TOTAL <= LDS_BYTES, "MLA LDS");
            for (int rp_ = 0; rp_ < 1 + (int)((PROBE_DBL >> 16) & 1u); ++rp_)
            for (int u = vcu; u < BATCH * 4 * 8; u += G) { const int bh = u >> 3, y = 7 - (u & 7), b = bh >> 2, h = bh & 3;
                const int r0 = (wave < 4) ? (128 * y + 32 * wave) : (128 * (15 - y) + 32 * (wave - 4));
                const size_t rb = (size_t)b * SEQ;
                B::unit(alds, Qb + (rb + r0) * 768 + 192 * h, 768, KV + rb * 1024 + 256 * h, 1024, KR + rb * 64, 64, KV + rb * 1024 + 256 * h + 128, 1024,
                        MIX + (rb + r0) * 1024 + 512 + 128 * h, 1024, r0, 0, 32 - 2 * y, 0x7fffffffu, 1.0f, 0.f); }
        }
        {
            typedef att::Body<64, 0, 64, true> B;
            static_assert(B::LDS_TOTAL <= LDS_BYTES, "SWA LDS");
            for (int rp_ = 0; rp_ < 1 + (int)((PROBE_DBL >> 17) & 1u); ++rp_)
            for (int u = vcu; u < BATCH * 8 * 8; u += G) { const int bh = u >> 3, qb = u & 7, b = bh >> 3, h = bh & 7, gkv = h >> 2;
                LAS float* tb = (LAS float*)(alds + B::OFF_BIAS);
                if (tid < 384) { const int dist = 256 - tid; tb[tid] = (dist >= 0 && dist < 128) ? rel_bias[t5_bucket(dist) * 8 + h] * L2E : 0.f; }
                const int r0 = 256 * qb + 32 * wave; const int kb0 = qb == 0 ? 0 : 256 * qb - 128; const int NT = (256 * qb + 256 - kb0) / 64;
                const size_t rb = (size_t)b * SEQ;
                B::unit(alds, PROJ + (rb + r0) * D_IN_PAD + 64 * h, D_IN_PAD, PROJ + rb * D_IN_PAD + 512 + 64 * gkv, D_IN_PAD, nullptr, 0, PROJ + rb * D_IN_PAD + 640 + 64 * gkv, D_IN_PAD,
                        MIX + (rb + r0) * 1024 + 64 * h, 1024, r0, kb0, NT, 128u, 0.125f * L2E, sinks[h] * L2E); }
        }
    }
    SEAM(6);
    PHASE(7) { bf16* MIX = WSP(bf16, WS_MIX); bf16* WO = WSP(bf16, WS_WO); float* X = XOUT; float* MOD = WSP(float, WS_MOD); const float* norm_ffn2 = LDP(16); bf16* H = WSP(bf16, WS_H); float* STATX = WSP(float, WS_STATX); pg8::Gemm g{MIX, WO, M, D_MODEL, D_MODEL, D_MODEL}; pg8::StaticOrder S; S.init(M, D_MODEL, G, bx);
        pg8::EpiResid<true> E{X, X, MOD + 5 * D_MODEL, norm_ffn2, MOD + 7 * D_MODEL, H, STATX, 1.0f};
        pg8::gemm_phase<pg8::EpiResid<true>, pg8::StaticOrder, true, true>(lds, g, S, E); }
    SEAM(7);
    PHASE(8) { bf16* H = WSP(bf16, WS_H); bf16* W2GU = WSP(bf16, WS_W2GU); bf16* ACT = WSP(bf16, WS_ACT); float* STATX = WSP(float, WS_STATX); float* BIAS3 = WSP(float, WS_BIAS3); pg8::Gemm g{H, W2GU, M, 2 * D_FF, D_MODEL, D_MODEL}; pg8::StaticOrder S; S.init(M, 2 * D_FF, G, bx); pg8::EpiSwiglu<true> E{ACT, STATX, BIAS3, RSL, D_FF};
        pg8::gemm_phase<pg8::EpiSwiglu<true>, pg8::StaticOrder, true, true>(lds, g, S, E); }
    SEAM(8);
    PHASE(9) { bf16* ACT = WSP(bf16, WS_ACT); bf16* W2D = WSP(bf16, WS_W2D); float* X = XOUT; float* MOD = WSP(float, WS_MOD); pg8::Gemm g{ACT, W2D, M, D_MODEL, D_FF, D_FF}; pg8::StaticOrder S; S.init(M, D_MODEL, G, bx);
        pg8::EpiResid<false> E{X, X, MOD + 8 * D_MODEL, nullptr, nullptr, nullptr, nullptr, 0.5f};
        pg8::gemm_phase<pg8::EpiResid<false>, pg8::StaticOrder, true, true>(lds, g, S, E); }
    SEAM(9);
    PHASE(10) { const float* norm_final = LDP(21); float* X = XOUT;
        f32x4 gg[4];
#pragma unroll
        for (int j = 0; j < 4; ++j) gg[j] = ((const f32x4*)norm_final)[lane + 64 * j];
        for (int row = gw; row < M; row += NGW) { f32x4* xr = (f32x4*)(X + (size_t)row * D_MODEL) + lane; f32x4 v[4]; float s = 0.f;
#pragma unroll
            for (int j = 0; j < 4; ++j) { v[j] = xr[64 * j]; s += (v[j].x * v[j].x + v[j].y * v[j].y) + (v[j].z * v[j].z + v[j].w * v[j].w); }
            const float rstd = 1.0f / sqrtf(wave_sum(s) * (1.0f / D_MODEL) + EPS);
#pragma unroll
            for (int j = 0; j < 4; ++j) xr[64 * j] = v[j] * rstd * gg[j]; }
    }
#undef IN
#undef SEAM
#undef PHASE
#undef LDP
#undef WSP
#undef XOUT
#undef RSL
}

constexpr int N_PHASES = 11;

extern "C" void kernel_launch(void* const* d_in, const int* in_sizes, int n_in, void* d_out, int out_size, void* d_ws, size_t ws_size, hipStream_t stream) {
    static int grid = 0;
    if (grid == 0) {
        if (n_in != 22 || out_size != M * D_MODEL || ws_size < WS_END) { fprintf(stderr, "kernel_launch: unexpected shapes (n_in %d out %d ws %zu)\n", n_in, out_size, ws_size); grid = -1; return; }
        int dev = 0, cus = 0, per_cu = 0;
        hipGetDevice(&dev); hipDeviceGetAttribute(&cus, hipDeviceAttributeMultiprocessorCount, dev);
        if (hipFuncSetAttribute((const void*)fwd_kernel, hipFuncAttributeMaxDynamicSharedMemorySize, LDS_BYTES) != hipSuccess) { fprintf(stderr, "kernel_launch: hipFuncSetAttribute failed\n"); grid = -1; return; }
        if (hipOccupancyMaxActiveBlocksPerMultiprocessor(&per_cu, (const void*)fwd_kernel, NWAVES * 64, LDS_BYTES) != hipSuccess || per_cu < 1) { fprintf(stderr, "kernel_launch: occupancy query says %d\n", per_cu); grid = -1; return; }
        grid = cus;
    }
    if (grid < 0) return;
    if (hipMemsetAsync((char*)d_ws + WS_CTL, 0, 65536, stream) != hipSuccess) { fprintf(stderr, "kernel_launch: memset failed\n"); return; }
    Args a{};
    for (int i = 0; i < 22; ++i) a.in[i] = (const float*)d_in[i];
    a.out = (float*)d_out; a.ws = (unsigned char*)d_ws; a.ph_lo = 0; a.ph_hi = N_PHASES;
    void* kargs[] = {&a};
    hipError_t e = hipLaunchCooperativeKernel((const void*)fwd_kernel, dim3(grid), dim3(NWAVES * 64), kargs, LDS_BYTES, stream);
    if (e != hipSuccess) fprintf(stderr, "cooperative launch failed: %s (grid %d)\n", hipGetErrorString(e), grid);
}
```
